# Optimizing an MI355X kernel written in HIP

```python
import jax, jax.numpy as jnp
from jax import lax
import numpy as np

D_MODEL = 2048
BATCH = 1
SEQ = 8192
DEPTH = 1
DEC_BATCH = 16
DEC_SEQ = 16
PAST_LEN = 2048

CHUNK = 64
Q_BLOCK = 128
H_SB = 8
D_SB = 128
H_RET = 4
DK_RET = 256
DV_RET = 256
D_FF = 5632
ROPE_BASE = 10000.0
EPS = 1e-6
SB_W = H_SB * D_SB
RET_QK_W = H_RET * DK_RET
RET_V_W = H_RET * DV_RET
D_IN = 3 * SB_W + 2 * RET_QK_W + 2 * RET_V_W
D_MIX = SB_W + RET_V_W
SPLITS = [SB_W, 2 * SB_W, 3 * SB_W, 3 * SB_W + RET_QK_W, 3 * SB_W + 2 * RET_QK_W,
          3 * SB_W + 2 * RET_QK_W + RET_V_W]

kernel_name = "stickbreak_retention_macaron_stream"


def _rmsnorm(x, w):
    xf = x.astype(jnp.float32)
    y = xf * lax.rsqrt(jnp.mean(xf * xf, axis=-1, keepdims=True) + EPS)
    return (y * w.astype(jnp.float32)).astype(x.dtype)


def _swiglu(x, w_gate, w_up, w_down):
    return (jax.nn.silu(x @ w_gate) * (x @ w_up)) @ w_down


def _heads(t, n):
    b, s, _ = t.shape
    return t.reshape(b, s, n, -1)


def _rotary(x, pos):
    xf = x.astype(jnp.float32)
    half = xf.shape[-1] // 2
    inv = ROPE_BASE ** (-jnp.arange(half, dtype=jnp.float32) / half)
    ang = pos.astype(jnp.float32)[:, None] * inv[None, :]
    cos = jnp.cos(ang)[None, :, None, :]
    sin = jnp.sin(ang)[None, :, None, :]
    x1, x2 = xf[..., :half], xf[..., half:]
    return jnp.concatenate([x1 * cos - x2 * sin, x1 * sin + x2 * cos], axis=-1)


def _bhsd(t):
    return t.transpose(0, 2, 1, 3)


def _pre(x, pos, ffn1_norm, ffn1_w_gate, ffn1_w_up, ffn1_w_down, mix_norm, w_in, sb_q_norm, sb_k_norm):
    x = x + 0.5 * _swiglu(_rmsnorm(x, ffn1_norm), ffn1_w_gate, ffn1_w_up, ffn1_w_down)
    p = _rmsnorm(x, mix_norm) @ w_in
    sq, sk, sv, rq, rk, rv, g = jnp.split(p, SPLITS, axis=-1)
    sq = _bhsd(_rmsnorm(_heads(sq, H_SB), sb_q_norm)).astype(jnp.float32)
    sk = _bhsd(_rmsnorm(_heads(sk, H_SB), sb_k_norm))
    sv = _bhsd(_heads(sv, H_SB))
    rq = _bhsd(_rotary(_heads(rq, H_RET), pos))
    rk = _bhsd(_rotary(_heads(rk, H_RET), pos)) * (DK_RET ** -0.5)
    rv = _bhsd(_heads(rv, H_RET)).astype(jnp.float32)
    return x, sq, sk, sv, rq, rk, rv, g


def _post(x, sb_o, ret_o, gate, ret_out_norm, w_out, ffn2_norm, ffn2_w_gate, ffn2_w_up, ffn2_w_down, final_norm):
    b, _, s, _ = sb_o.shape
    sb = sb_o.transpose(0, 2, 1, 3).reshape(b, s, SB_W)
    r = ret_o.transpose(0, 2, 1, 3)
    r = r * lax.rsqrt(jnp.mean(r * r, axis=-1, keepdims=True) + EPS)
    r = r * ret_out_norm.astype(jnp.float32).reshape(H_RET, DV_RET)
    r = r.reshape(b, s, RET_V_W) * jax.nn.silu(gate.astype(jnp.float32))
    x = x + jnp.concatenate([sb, r], axis=-1).astype(x.dtype) @ w_out
    x = x + 0.5 * _swiglu(_rmsnorm(x, ffn2_norm), ffn2_w_gate, ffn2_w_up, ffn2_w_down)
    return _rmsnorm(x, final_norm)


def _sb_weights(q, k, q_pos, k_pos):
    z = jnp.einsum('bhqd,bhkd->bhqk', q, k.astype(jnp.float32)) * (D_SB ** -0.5)
    mask = k_pos[None, :] < q_pos[:, None]
    log_keep = jnp.where(mask, jax.nn.log_sigmoid(-z), 0.0)
    log_rest = lax.cumsum(log_keep, axis=3, reverse=True) - log_keep
    return jnp.where(mask, jnp.exp(jax.nn.log_sigmoid(z) + log_rest), 0.0)


def _sb_prompt(q, k, v):
    b, h, s, d = q.shape
    k_pos = jnp.arange(s)
    vf = v.astype(jnp.float32)

    def block(i):
        start = i * Q_BLOCK
        qb = lax.dynamic_slice_in_dim(q, start, Q_BLOCK, axis=2)
        a = _sb_weights(qb, k, start + jnp.arange(Q_BLOCK), k_pos)
        return jnp.einsum('bhqk,bhkd->bhqd', a, vf)

    o = lax.map(block, jnp.arange(s // Q_BLOCK))
    return jnp.moveaxis(o, 0, 2).reshape(b, h, s, d)


def _sb_sample(q, k_new, v_new, cache_k, cache_v):
    p = cache_k.shape[2]
    t = q.shape[2]
    k_all = jnp.concatenate([cache_k.astype(jnp.float32), k_new.astype(jnp.float32)], axis=2)
    v_all = jnp.concatenate([cache_v.astype(jnp.float32), v_new.astype(jnp.float32)], axis=2)
    a = _sb_weights(q, k_all, p + jnp.arange(t), jnp.arange(p + t))
    return jnp.einsum('bhqk,bhkd->bhqd', a, v_all)


def _ret_decays(length):
    lg = jnp.log(1.0 - 2.0 ** (-5.0 - jnp.arange(H_RET, dtype=jnp.float32)))
    i = jnp.arange(length, dtype=jnp.float32)
    diff = i[:, None] - i[None, :]
    intra = jnp.where(diff >= 0, jnp.exp(lg[:, None, None] * jnp.maximum(diff, 0.0)), 0.0)
    q_dec = jnp.exp(lg[:, None] * (i + 1.0))
    k_dec = jnp.exp(lg[:, None] * (length - 1.0 - i))
    c_dec = jnp.exp(lg * length)
    return intra, q_dec, k_dec, c_dec


def _ret_chunk(state, q, k, v, decays):
    intra, q_dec, k_dec, c_dec = decays
    scores = jnp.einsum('bhid,bhjd->bhij', q, k) * intra[None]
    o = (jnp.einsum('bhij,bhje->bhie', scores, v)
         + jnp.einsum('bhid,bhde->bhie', q, state) * q_dec[None, :, :, None])
    new_state = (c_dec[None, :, None, None] * state
                 + jnp.einsum('bhjd,bhje->bhde', k * k_dec[None, :, :, None], v))
    return new_state, o


def _ret_prompt(q, k, v):
    b, h, s, _ = q.shape
    nc = s // CHUNK

    def chunks(t):
        return jnp.moveaxis(t.reshape(b, h, nc, CHUNK, t.shape[-1]), 2, 0)

    dec = _ret_decays(CHUNK)
    s0 = jnp.zeros((b, h, DK_RET, DV_RET), jnp.float32)
    s_final, o = lax.scan(lambda st, xs: _ret_chunk(st, xs[0], xs[1], xs[2], dec), s0,
                          (chunks(q), chunks(k), chunks(v)))
    return jnp.moveaxis(o, 0, 2).reshape(b, h, s, DV_RET), s_final


def setup_inputs(seed: int = 0) -> dict:
    key = jax.random.key(seed)
    ks = jax.random.split(key, 24)
    f32 = jnp.float32

    def w(k, shape, fan_in):
        return jax.random.normal(k, shape, f32) * (fan_in ** -0.5)

    def gain(k, n):
        return 1.0 + 0.01 * jax.random.normal(k, (DEPTH, n), f32)

    return {
        "x_prompt": jax.random.normal(ks[0], (BATCH, SEQ, D_MODEL), f32),
        "x_sample": jax.random.normal(ks[1], (DEC_BATCH, DEC_SEQ, D_MODEL), f32),
        "cache_sb_k": jax.random.normal(ks[2], (DEPTH, DEC_BATCH, H_SB, PAST_LEN, D_SB), f32),
        "cache_sb_v": jax.random.normal(ks[3], (DEPTH, DEC_BATCH, H_SB, PAST_LEN, D_SB), f32),
        "state_ret": 0.5 * jax.random.normal(ks[4], (DEPTH, DEC_BATCH, H_RET, DK_RET, DV_RET), f32),
        "ffn1_norm": gain(ks[5], D_MODEL),
        "ffn1_w_gate": w(ks[6], (DEPTH, D_MODEL, D_FF), D_MODEL),
        "ffn1_w_up": w(ks[7], (DEPTH, D_MODEL, D_FF), D_MODEL),
        "ffn1_w_down": w(ks[8], (DEPTH, D_FF, D_MODEL), D_FF),
        "mix_norm": gain(ks[9], D_MODEL),
        "w_in": w(ks[10], (DEPTH, D_MODEL, D_IN), D_MODEL),
        "sb_q_norm": gain(ks[11], D_SB),
        "sb_k_norm": gain(ks[12], D_SB),
        "ret_out_norm": gain(ks[13], RET_V_W),
        "w_out": w(ks[14], (DEPTH, D_MIX, D_MODEL), D_MIX),
        "ffn2_norm": gain(ks[15], D_MODEL),
        "ffn2_w_gate": w(ks[16], (DEPTH, D_MODEL, D_FF), D_MODEL),
        "ffn2_w_up": w(ks[17], (DEPTH, D_MODEL, D_FF), D_MODEL),
        "ffn2_w_down": w(ks[18], (DEPTH, D_FF, D_MODEL), D_FF),
        "final_norm": gain(ks[19], D_MODEL),
    }


def reference(x_prompt, x_sample, cache_sb_k, cache_sb_v, state_ret,
              ffn1_norm, ffn1_w_gate, ffn1_w_up, ffn1_w_down, mix_norm, w_in,
              sb_q_norm, sb_k_norm, ret_out_norm, w_out,
              ffn2_norm, ffn2_w_gate, ffn2_w_up, ffn2_w_down, final_norm):
    past = cache_sb_k.shape[3]
    pos_p = jnp.arange(x_prompt.shape[1])
    pos_s = past + jnp.arange(x_sample.shape[1])
    xp, xs = x_prompt, x_sample
    kp_l, vp_l, sp_l, ks_l, vs_l, ss_l = [], [], [], [], [], []
    for l in range(DEPTH):
        pre = (ffn1_norm[l], ffn1_w_gate[l], ffn1_w_up[l], ffn1_w_down[l], mix_norm[l], w_in[l],
               sb_q_norm[l], sb_k_norm[l])
        post = (ret_out_norm[l], w_out[l], ffn2_norm[l], ffn2_w_gate[l], ffn2_w_up[l],
                ffn2_w_down[l], final_norm[l])
        hp, sq, sk, sv, rq, rk, rv, g = _pre(xp, pos_p, *pre)
        sb_o = _sb_prompt(sq, sk, sv)
        ret_o, st_p = _ret_prompt(rq, rk, rv)
        xp = _post(hp, sb_o, ret_o, g, *post)
        kp_l.append(sk)
        vp_l.append(sv)
        sp_l.append(st_p.astype(x_prompt.dtype))
        hs, sq, sk, sv, rq, rk, rv, g = _pre(xs, pos_s, *pre)
        sb_o = _sb_sample(sq, sk, sv, cache_sb_k[l], cache_sb_v[l])
        st_s, ret_o = _ret_chunk(state_ret[l].astype(jnp.float32), rq, rk, rv,
                                 _ret_decays(x_sample.shape[1]))
        xs = _post(hs, sb_o, ret_o, g, *post)
        ks_l.append(sk.astype(cache_sb_k.dtype))
        vs_l.append(sv.astype(cache_sb_v.dtype))
        ss_l.append(st_s.astype(state_ret.dtype))
    return (xp, xs, jnp.stack(kp_l), jnp.stack(vp_l), jnp.stack(sp_l),
            jnp.stack(ks_l), jnp.stack(vs_l), jnp.stack(ss_l))
```

```cpp
#include <hip/hip_runtime.h>
#include <hip/hip_cooperative_groups.h>
#include <cstdio>
namespace cg = cooperative_groups;

#define DI __device__ __forceinline__
typedef unsigned short bf16_t;
typedef short bf16x8 __attribute__((ext_vector_type(8)));
typedef short s16x4 __attribute__((ext_vector_type(4)));
typedef float f32x4 __attribute__((ext_vector_type(4)));
typedef float f32x2 __attribute__((ext_vector_type(2)));
typedef float f32x16 __attribute__((ext_vector_type(16)));
typedef unsigned u32x4 __attribute__((ext_vector_type(4)));
typedef unsigned u32x2 __attribute__((ext_vector_type(2)));

constexpr int DM = 2048, SEQ = 8192, NSAMP = 256, MTOK = SEQ + NSAMP, DFF = 5632, DIN = 7168, PAST = 2048, DECS = 16, DECB = 16;
constexpr float EPS = 1e-6f;

constexpr size_t al256(size_t x) { return (x + 255) & ~(size_t)255; }
constexpr size_t WS_W1T = 0;
constexpr size_t WS_WD1T = WS_W1T + (size_t)2 * DFF * DM * 2;
constexpr size_t WS_WINT = WS_WD1T + (size_t)DM * DFF * 2;
constexpr size_t WS_WOT = WS_WINT + (size_t)DIN * DM * 2;
constexpr size_t WS_W2T = WS_WOT + (size_t)DM * DM * 2;
constexpr size_t WS_WD2T = WS_W2T + (size_t)2 * DFF * DM * 2;
constexpr size_t WS_XN = WS_WD2T + (size_t)DM * DFF * 2;
constexpr size_t WS_H = WS_XN + (size_t)MTOK * DM * 2;
constexpr size_t WS_ST = WS_H;
constexpr size_t WS_X1 = WS_H + (size_t)MTOK * DFF * 2;
constexpr size_t WS_SSQ = WS_X1 + (size_t)MTOK * DM * 4;
constexpr size_t WS_QB = al256(WS_SSQ + (size_t)4 * MTOK * 4);
constexpr size_t SEG_B = (size_t)MTOK * 1024 * 2;
constexpr size_t WS_KB = WS_QB + SEG_B;
constexpr size_t WS_VT = WS_KB + SEG_B;
constexpr size_t WS_RQ = WS_VT + SEG_B;
constexpr size_t WS_RK = WS_RQ + SEG_B;
constexpr size_t WS_RKDT = WS_RK + SEG_B;
constexpr size_t WS_RVT = WS_RKDT + SEG_B;
constexpr size_t WS_G = WS_RVT + SEG_B;
constexpr size_t WS_MIX = WS_G + SEG_B;
constexpr size_t WS_KVT = WS_MIX + (size_t)MTOK * DM * 2;
constexpr size_t WS_ROPE = WS_KVT + (size_t)512 * 65536 * 2;
constexpr size_t WS_END = WS_ROPE + (size_t)2 * SEQ * 128 * 4;
static_assert((size_t)576 * 65536 * 2 <= (size_t)MTOK * DFF * 2, "ST must fit in H");

constexpr size_t O_Y = 0;
constexpr size_t O_KP = (size_t)MTOK * DM;
constexpr size_t O_VP = O_KP + (size_t)8 * SEQ * 128;
constexpr size_t O_SP = O_VP + (size_t)8 * SEQ * 128;
constexpr size_t O_KS = O_SP + (size_t)4 * 65536;
constexpr size_t O_VS = O_KS + (size_t)DECB * 8 * DECS * 128;
constexpr size_t O_SS = O_VS + (size_t)DECB * 8 * DECS * 128;

DI unsigned pk_bf16(float a, float b) {
    typedef __bf16 bf2 __attribute__((ext_vector_type(2)));
    bf2 v; v[0] = (__bf16)a; v[1] = (__bf16)b; return __builtin_bit_cast(unsigned, v);
}
DI bf16_t to_bf16(float a) { return __builtin_bit_cast(bf16_t, (__bf16)a); }
DI float silu_f(float g) { return g * __builtin_amdgcn_rcpf(1.f + __expf(-g)); }
DI float softplus_f(float z) { return fmaxf(z, 0.f) + __logf(1.f + __expf(-fabsf(z))); }
DI float log2_gamma(int h) { return __log2f(1.0f - exp2f(-5.0f - (float)h)); }

namespace pg8 {
#define PG8_LAS __attribute__((address_space(3)))
typedef unsigned short bf16_t;
typedef short bf16x8 __attribute__((ext_vector_type(8)));
typedef float f32x4 __attribute__((ext_vector_type(4)));
typedef unsigned u32x4 __attribute__((ext_vector_type(4)));
constexpr int BM = 256, BK = 64, HALF = 128, HTB = HALF * BK * 2  , STAGE_BYTES = 8 * HTB, NXCD = 8, WGM = 8;

__host__ __device__ __forceinline__ int lds_byte(int r, int c) { const int st = (r >> 4) * 2 + (c >> 5), rr = r & 15, cc = c & 31, ob = rr * 64 + cc * 2; return st * 1024 + (ob ^ (((ob >> 9) & 1) << 5)); }
__host__ __device__ __forceinline__ void stage_rc(int b, int& R, int& C) { const int st = b / 1024, sb = b % 1024, swz = sb ^ (((sb >> 9) & 1) << 5); R = (st >> 1) * 16 + swz / 64; C = (st & 1) * 32 + (swz % 64) / 2; }
__host__ __device__ __forceinline__ int perm32(int rho) { const int n = rho >> 4, i = rho & 15; return 8 * (i >> 2) + 4 * n + (i & 3); }

struct Unit { int pm, pn; };
struct Gemm { const bf16_t* A; const bf16_t* Bt; int M, N, K; };

struct StaticOrder {
    int nM, nN, nwg, G, c;
    __host__ __device__ void init(int M, int N, int G_, int c_) { nM = M / BM; nN = N / BM; nwg = nM * nN; G = G_; c = c_; }
    __host__ __device__ bool next(int i, Unit& u) const {
        const long L = (long)i * G + c; if (L >= nwg) return false;
        int wgid = (int)L; { const int q = nwg / NXCD, r = nwg % NXCD, xcd = wgid % NXCD, off = wgid / NXCD; wgid = (xcd < r ? xcd * (q + 1) : r * (q + 1) + (xcd - r) * q) + off; }
        const int nig = WGM * nN, gid = wgid / nig, fm = gid * WGM, gsz = (nM - fm) < WGM ? (nM - fm) : WGM;
        u.pm = fm + ((wgid % nig) % gsz); u.pn = (wgid % nig) / gsz; return true;
    }
    __device__ __forceinline__ void a_ready(const Unit&) const {}
    __device__ __forceinline__ void done(const Unit&) const {}
};
template <class Epi, class Sched, bool STAMP = false>
__device__ __forceinline__ void gemm_phase(PG8_LAS unsigned char* lds, const Gemm g, const Sched& S, const Epi& E, unsigned long long* stamps) {
    int tid_ = threadIdx.x; asm volatile("" : "+v"(tid_));
    const int tid = tid_, wid = __builtin_amdgcn_readfirstlane(tid >> 6), lane = tid & 63, wr = wid >> 2, wc = wid & 3, fr = lane & 15, fq = lane >> 4;
    const int K = g.K, nt = K / BK;
    int ts_lo = 0, ts_hi = 0, nts = 0; const unsigned long long rt_entry = STAMP ? (unsigned long long)wall_clock64() : 0ull;
#define PG8_STAMP() do { if (STAMP && wid == 0 && nts < 64) { const unsigned long long _c = (unsigned long long)clock64(); \
        ts_lo = (lane == nts) ? (int)(unsigned)_c : ts_lo; ts_hi = (lane == nts) ? (int)(unsigned)(_c >> 32) : ts_hi; ++nts; } } while (0)
    PG8_STAMP();
    unsigned voffA[2], voffB[2];
#pragma unroll
    for (int i = 0; i < 2; ++i) { int R, C; stage_rc(tid * 16 + i * 8192, R, C); const int Rb = Epi::PERM ? ((R & ~31) + perm32(R & 31)) : R;
        voffA[i] = (unsigned)(R * K + C) * 2u; voffB[i] = (unsigned)(Rb * K + C) * 2u; }
    const size_t kstep = (size_t)(BK * 2);
    const size_t hstep = (size_t)HALF * K * 2;
    const size_t tstep = 2 * hstep;
    const unsigned ldsw = (unsigned)wid * 1024u;
    const int aoff = lds_byte(wr * 64 + fr, fq * 8), boff = lds_byte(wc * 32 + fr, fq * 8);
#define PG8_SA(b, h) (((b) * 2 + (h)) * HTB)
#define PG8_SB(b, h) ((4 + (b) * 2 + (h)) * HTB)
#define PG8_STAGE(bufoff, gbase, voff) do { _Pragma("unroll") for (int _i = 0; _i < 2; ++_i) \
        __builtin_amdgcn_global_load_lds((const unsigned*)((const char*)(gbase) + (voff)[_i]), (PG8_LAS unsigned*)(lds + (bufoff) + ldsw + _i * 8192), 16, 0, 0); } while (0)
#define PG8_LDA(dst, b, h) do { _Pragma("unroll") for (int m = 0; m < 4; ++m) _Pragma("unroll") for (int k = 0; k < 2; ++k) dst[m][k] = *(const PG8_LAS bf16x8*)(lds + PG8_SA(b, h) + aoff + m * 2048 + k * 1024); } while (0)
#define PG8_LDB(dst, b, h) do { _Pragma("unroll") for (int n = 0; n < 2; ++n) _Pragma("unroll") for (int k = 0; k < 2; ++k) dst[n][k] = *(const PG8_LAS bf16x8*)(lds + PG8_SB(b, h) + boff + n * 2048 + k * 1024); } while (0)
#define PG8_MMA(ai, bj, At, Bt) do { __builtin_amdgcn_s_setprio(1); _Pragma("unroll") for (int m = 0; m < 4; ++m) _Pragma("unroll") for (int n = 0; n < 2; ++n) _Pragma("unroll") for (int k = 0; k < 2; ++k) \
        acc[ai][bj][m][n] = __builtin_amdgcn_mfma_f32_16x16x32_bf16(Bt[n][k], At[m][k], acc[ai][bj][m][n], 0, 0, 0); __builtin_amdgcn_s_setprio(0); } while (0)
#define PG8_WAIT_V(n) asm volatile("s_waitcnt vmcnt(" #n ")" ::: "memory")
#define PG8_WAIT_L(n) asm volatile("s_waitcnt lgkmcnt(" #n ")" ::: "memory")
#define PG8_BAR __builtin_amdgcn_s_barrier()
#define PG8_SCHED __builtin_amdgcn_sched_barrier(0)
    Unit cur, nxt; int ui = 0;
    if (!S.next(0, cur)) return;
    f32x4 acc[2][2][4][2];
#pragma unroll
    for (int a = 0; a < 2; ++a)
#pragma unroll
        for (int b = 0; b < 2; ++b)
#pragma unroll
            for (int m = 0; m < 4; ++m)
#pragma unroll
                for (int n = 0; n < 2; ++n) acc[a][b][m][n] = (f32x4){0.f, 0.f, 0.f, 0.f};
    bf16x8 At[4][2], B0[2][2], B1[2][2];
    const char* cA = (const char*)g.A + (size_t)cur.pm * tstep; const char* cB = (const char*)g.Bt + (size_t)cur.pn * tstep;
    S.a_ready(cur);
    PG8_STAGE(PG8_SB(0, 0), cB, voffB); PG8_STAGE(PG8_SA(0, 0), cA, voffA); PG8_STAGE(PG8_SB(0, 1), cB + hstep, voffB); PG8_STAGE(PG8_SA(0, 1), cA + hstep, voffA);
    if (wr == 1) PG8_BAR;
    PG8_WAIT_V(4); PG8_BAR;
    PG8_STAGE(PG8_SB(1, 0), cB + kstep, voffB); PG8_STAGE(PG8_SA(1, 0), cA + kstep, voffA); PG8_STAGE(PG8_SB(1, 1), cB + hstep + kstep, voffB);
    PG8_WAIT_V(6); PG8_BAR;
    PG8_STAMP();
    for (;;) {
        const bool has_next = S.next(ui + 1, nxt);
        const char* nA = has_next ? (const char*)g.A + (size_t)nxt.pm * tstep : cA; const char* nB = has_next ? (const char*)g.Bt + (size_t)nxt.pn * tstep : cB;
        for (int t = 0; t < nt; t += 2) {
            const bool last = (t == nt - 2);
            const char* a1 = cA + (size_t)(t + 1) * kstep;
            const char* a2 = last ? nA : cA + (size_t)(t + 2) * kstep; const char* b2 = last ? nB : cB + (size_t)(t + 2) * kstep;
            const char* a3 = a2 + kstep; const char* b3 = b2 + kstep;
            if (last && has_next) S.a_ready(nxt);
            PG8_LDB(B0, 0, 0); PG8_SCHED; PG8_LDA(At, 0, 0); PG8_STAGE(PG8_SA(1, 1), a1 + hstep, voffA);
            PG8_WAIT_L(8); PG8_BAR; PG8_WAIT_L(0); PG8_MMA(0, 0, At, B0); PG8_BAR; PG8_SCHED;
            PG8_LDB(B1, 0, 1); PG8_STAGE(PG8_SB(0, 0), b2, voffB);
            PG8_BAR; PG8_WAIT_L(0); PG8_MMA(0, 1, At, B1); PG8_BAR;
            PG8_LDA(At, 0, 1); PG8_STAGE(PG8_SA(0, 0), a2, voffA);
            PG8_BAR; PG8_WAIT_L(0); PG8_MMA(1, 0, At, B0); PG8_BAR; PG8_SCHED;
            PG8_STAGE(PG8_SB(0, 1), b2 + hstep, voffB);
            PG8_WAIT_V(6); PG8_BAR; PG8_MMA(1, 1, At, B1); PG8_BAR;
            PG8_LDB(B0, 1, 0); PG8_SCHED; PG8_LDA(At, 1, 0); PG8_STAGE(PG8_SA(0, 1), a2 + hstep, voffA);
            PG8_WAIT_L(8); PG8_BAR; PG8_WAIT_L(0); PG8_MMA(0, 0, At, B0); PG8_BAR; PG8_SCHED;
            PG8_LDB(B1, 1, 1); PG8_STAGE(PG8_SB(1, 0), b3, voffB);
            PG8_BAR; PG8_WAIT_L(0); PG8_MMA(0, 1, At, B1); PG8_BAR;
            PG8_LDA(At, 1, 1); PG8_STAGE(PG8_SA(1, 0), a3, voffA);
            PG8_BAR; PG8_WAIT_L(0); PG8_MMA(1, 0, At, B0); PG8_BAR; PG8_SCHED;
            PG8_STAGE(PG8_SB(1, 1), b3 + hstep, voffB);
            PG8_WAIT_V(6); PG8_BAR; PG8_MMA(1, 1, At, B1); PG8_BAR;
        }
        PG8_STAMP();
        if constexpr (!Epi::AFTER_DRAIN) { E(acc, cur, wr, wc, fr, fq); S.done(cur); }
        PG8_STAMP();
        if (!has_next) break;
#pragma unroll
        for (int a = 0; a < 2; ++a)
#pragma unroll
            for (int b = 0; b < 2; ++b)
#pragma unroll
                for (int m = 0; m < 4; ++m)
#pragma unroll
                    for (int n = 0; n < 2; ++n) acc[a][b][m][n] = (f32x4){0.f, 0.f, 0.f, 0.f};
        cur = nxt; cA = nA; cB = nB; ++ui;
    }
    PG8_WAIT_V(0);
    if (wr == 0) PG8_BAR;
    PG8_BAR;
    if constexpr (Epi::AFTER_DRAIN) { E.fused(acc, cur, wr, wc, fr, fq, lds, wid, lane); S.done(cur); }
    PG8_STAMP();
    if (STAMP && wid == 0) { stamps[lane] = lane < nts ? (((unsigned long long)(unsigned)ts_hi << 32) | (unsigned)ts_lo) : 0ull;
        if (lane == 62) stamps[62] = rt_entry; if (lane == 63) stamps[63] = (unsigned long long)wall_clock64(); }
#undef PG8_STAMP
#undef PG8_SA
#undef PG8_SB
#undef PG8_STAGE
#undef PG8_LDA
#undef PG8_LDB
#undef PG8_MMA
#undef PG8_WAIT_V
#undef PG8_WAIT_L
#undef PG8_BAR
#undef PG8_SCHED
}
}

using pg8::Unit;
typedef f32x4 AccT[2][2][4][2];

struct EpiSwiglu {
    static constexpr bool PERM = true, AFTER_DRAIN = false;
    bf16_t* H; const float* ssq;
    DI void operator()(const AccT& acc, const Unit& u, int wr, int wc, int fr_, int fq_) const {
        int fr = fr_, fq = fq_; asm volatile("" : "+v"(fr), "+v"(fq));
        const int row0 = u.pm * 256 + wr * 64 + fr, col0 = u.pn * 128 + wc * 32 + 8 * fq;
#pragma unroll
        for (int ai = 0; ai < 2; ++ai)
#pragma unroll
            for (int m = 0; m < 4; ++m) {
                const int row = row0 + ai * 128 + m * 16;
                const float r = rsqrtf(ssq[row] * (1.0f / DM) + EPS);
                float hv[8];
#pragma unroll
                for (int n = 0; n < 2; ++n)
#pragma unroll
                    for (int j = 0; j < 4; ++j) { const float g = acc[ai][0][m][n][j] * r, up = acc[ai][1][m][n][j] * r; hv[n * 4 + j] = silu_f(g) * up; }
                u32x4 w; w.x = pk_bf16(hv[0], hv[1]); w.y = pk_bf16(hv[2], hv[3]); w.z = pk_bf16(hv[4], hv[5]); w.w = pk_bf16(hv[6], hv[7]);
                *(u32x4*)(H + (size_t)row * DFF + col0) = w;
            }
    }
};

struct EpiResid {
    static constexpr bool PERM = true, AFTER_DRAIN = false;
    const float* xa; const float* xs; float* xo; bf16_t* xb; float* ssq; float scale;
    DI void operator()(const AccT& acc, const Unit& u, int wr, int wc, int fr_, int fq_) const {
        int fr = fr_, fq = fq_; asm volatile("" : "+v"(fr), "+v"(fq));
        const int row0 = u.pm * 256 + wr * 64 + fr, col0 = u.pn * 256 + wc * 32 + 8 * fq;
        const float* src = (u.pm == 32) ? xs - (size_t)SEQ * DM : xa;
#pragma unroll
        for (int ai = 0; ai < 2; ++ai)
#pragma unroll
            for (int m = 0; m < 4; ++m) {
                const int row = row0 + ai * 128 + m * 16;
                float sq = 0.f;
#pragma unroll
                for (int bj = 0; bj < 2; ++bj) {
                    const size_t off = (size_t)row * DM + col0 + bj * 128;
                    const f32x4 x0 = *(const f32x4*)(src + off), x1 = *(const f32x4*)(src + off + 4);
                    const f32x4 y0 = x0 + acc[ai][bj][m][0] * scale, y1 = x1 + acc[ai][bj][m][1] * scale;
                    *(f32x4*)(xo + off) = y0; *(f32x4*)(xo + off + 4) = y1;
                    u32x4 w; w.x = pk_bf16(y0[0], y0[1]); w.y = pk_bf16(y0[2], y0[3]); w.z = pk_bf16(y1[0], y1[1]); w.w = pk_bf16(y1[2], y1[3]);
                    *(u32x4*)(xb + off) = w;
                    sq += (y0[0] * y0[0] + y0[1] * y0[1]) + (y0[2] * y0[2] + y0[3] * y0[3]) + (y1[0] * y1[0] + y1[1] * y1[1]) + (y1[2] * y1[2] + y1[3] * y1[3]);
                }
                sq += __shfl_xor(sq, 16); sq += __shfl_xor(sq, 32);
                if (fq == 0) atomicAdd(ssq + row, sq);
                asm volatile("" ::: "memory");
            }
    }
};

struct EpiIn {
    static constexpr bool PERM = true, AFTER_DRAIN = false;
    const float* ssq; const float* qn; const float* kn; const float* rope; float* out; unsigned char* ws; float* tbl  ;
    DI void operator()(const AccT& acc, const Unit& u, int wr, int wc, int fr_, int fq_) const {
        int fr = fr_, fq = fq_; asm volatile("" : "+v"(fr), "+v"(fq));
        const int seg = u.pn >> 2, sub = u.pn & 3;
        const bool samp = (u.pm == 32);
        const int rl0 = wr * 64 + fr;
        const int cw = wc * 32 + 8 * fq;
        if (seg <= 1) {
            float rr[2][4];
#pragma unroll
            for (int ai = 0; ai < 2; ++ai)
#pragma unroll
                for (int m = 0; m < 4; ++m) {
                    const int rl = rl0 + ai * 128 + m * 16;
                    const float r = rsqrtf(ssq[u.pm * 256 + rl] * (1.0f / DM) + EPS); rr[ai][m] = r;
#pragma unroll
                    for (int bj = 0; bj < 2; ++bj) {
                        const f32x4 a = acc[ai][bj][m][0] * r, b = acc[ai][bj][m][1] * r;
                        float s = (a[0] * a[0] + a[1] * a[1]) + (a[2] * a[2] + a[3] * a[3]) + (b[0] * b[0] + b[1] * b[1]) + (b[2] * b[2] + b[3] * b[3]);
                        s += __shfl_xor(s, 16); s += __shfl_xor(s, 32);
                        if (fq == 0) tbl[(rl * 2 + bj) * 4 + wc] = s;
                    }
                }
            asm volatile("s_waitcnt lgkmcnt(0)" ::: "memory"); __builtin_amdgcn_s_barrier(); asm volatile("" ::: "memory");
            const float* gn = seg == 0 ? qn : kn;
            const float post = seg == 0 ? 0.08838834764831845f : 1.0f;
            f32x4 g0 = *(const f32x4*)(gn + cw), g1 = *(const f32x4*)(gn + cw + 4);
            g0 *= post; g1 *= post;
            bf16_t* dstb = (bf16_t*)(ws + (seg == 0 ? WS_QB : WS_KB));
#pragma unroll
            for (int ai = 0; ai < 2; ++ai)
#pragma unroll
                for (int m = 0; m < 4; ++m) {
                    const int rl = rl0 + ai * 128 + m * 16;
#pragma unroll
                    for (int bj = 0; bj < 2; ++bj) {
                        const f32x4 t = *(const f32x4*)(tbl + (rl * 2 + bj) * 4);
                        const float hr = rsqrtf(((t[0] + t[1]) + (t[2] + t[3])) * (1.0f / 128.0f) + EPS) * rr[ai][m];
                        const f32x4 a = acc[ai][bj][m][0] * hr * g0, b = acc[ai][bj][m][1] * hr * g1;
                        const int head = sub * 2 + bj;
                        size_t idx;
                        if (!samp) idx = ((size_t)head * SEQ + (u.pm * 256 + rl)) * 128 + cw;
                        else { const int sr = rl, b_ = sr >> 4, t_ = sr & 15; idx = (size_t)8 * SEQ * 128 + (((size_t)(b_ * 8 + head)) * 16 + t_) * 128 + cw; }
                        u32x4 w; w.x = pk_bf16(a[0], a[1]); w.y = pk_bf16(a[2], a[3]); w.z = pk_bf16(b[0], b[1]); w.w = pk_bf16(b[2], b[3]);
                        *(u32x4*)(dstb + idx) = w;
                        if (seg == 1) {
                            float* o = samp ? out + O_KS + (idx - (size_t)8 * SEQ * 128) : out + O_KP + idx;
                            *(f32x4*)o = a; *(f32x4*)(o + 4) = b;
                        }
                    }
                    asm volatile("" ::: "memory");
                }
            return;
        }
#pragma unroll
        for (int ai = 0; ai < 2; ++ai)
#pragma unroll
            for (int m = 0; m < 4; ++m) {
                const int rl = rl0 + ai * 128 + m * 16, row = u.pm * 256 + rl;
                const float r = rsqrtf(ssq[row] * (1.0f / DM) + EPS);
                const int b_ = rl >> 4, t_ = rl & 15;
                if (seg == 2) {
                    bf16_t* vt = (bf16_t*)(ws + WS_VT);
#pragma unroll
                    for (int bj = 0; bj < 2; ++bj) {
                        const int head = sub * 2 + bj;
                        const f32x4 a = acc[ai][bj][m][0] * r, b = acc[ai][bj][m][1] * r;
                        if (!samp) {
                            float* o = out + O_VP + ((size_t)head * SEQ + row) * 128 + cw; *(f32x4*)o = a; *(f32x4*)(o + 4) = b;
                            bf16_t* v = vt + ((size_t)head * 128 + cw) * SEQ + row;
#pragma unroll
                            for (int j = 0; j < 4; ++j) { v[(size_t)j * SEQ] = to_bf16(a[j]); v[(size_t)(4 + j) * SEQ] = to_bf16(b[j]); }
                        } else {
                            float* o = out + O_VS + (((size_t)(b_ * 8 + head)) * 16 + t_) * 128 + cw; *(f32x4*)o = a; *(f32x4*)(o + 4) = b;
                            bf16_t* v = vt + (size_t)8 * 128 * SEQ + (((size_t)(b_ * 8 + head)) * 128 + cw) * 16 + t_;
#pragma unroll
                            for (int j = 0; j < 4; ++j) { v[j * 16] = to_bf16(a[j]); v[(4 + j) * 16] = to_bf16(b[j]); }
                        }
                    }
                } else if (seg == 3 || seg == 4) {
                    const int head = sub, pos = samp ? PAST + t_ : row;
                    const float* cs = rope + (size_t)pos * 128 + cw; const float* sn = cs + (size_t)SEQ * 128;
                    const f32x4 c0 = *(const f32x4*)cs, c1 = *(const f32x4*)(cs + 4), s0 = *(const f32x4*)sn, s1 = *(const f32x4*)(sn + 4);
                    const float sc = seg == 3 ? r : r * 0.0625f;
                    const f32x4 xa0 = acc[ai][0][m][0] * sc, xa1 = acc[ai][0][m][1] * sc, xb0 = acc[ai][1][m][0] * sc, xb1 = acc[ai][1][m][1] * sc;
                    const f32x4 lo0 = xa0 * c0 - xb0 * s0, lo1 = xa1 * c1 - xb1 * s1, hi0 = xa0 * s0 + xb0 * c0, hi1 = xa1 * s1 + xb1 * c1;
                    bf16_t* d = (bf16_t*)(ws + (seg == 3 ? WS_RQ : WS_RK));
                    const size_t idx = !samp ? ((size_t)head * SEQ + row) * 256 + cw : (size_t)4 * SEQ * 256 + (((size_t)(b_ * 4 + head)) * 16 + t_) * 256 + cw;
                    u32x4 w; w.x = pk_bf16(lo0[0], lo0[1]); w.y = pk_bf16(lo0[2], lo0[3]); w.z = pk_bf16(lo1[0], lo1[1]); w.w = pk_bf16(lo1[2], lo1[3]);
                    *(u32x4*)(d + idx) = w;
                    w.x = pk_bf16(hi0[0], hi0[1]); w.y = pk_bf16(hi0[2], hi0[3]); w.z = pk_bf16(hi1[0], hi1[1]); w.w = pk_bf16(hi1[2], hi1[3]);
                    *(u32x4*)(d + idx + 128) = w;
                    if (seg == 4) {
                        const float kd = exp2f(log2_gamma(head) * (float)(samp ? 15 - t_ : 63 - (row & 63)));
                        bf16_t* kt = (bf16_t*)(ws + WS_RKDT);
                        if (!samp) { bf16_t* v = kt + ((size_t)head * 256 + cw) * SEQ + row;
#pragma unroll
                            for (int j = 0; j < 4; ++j) { v[(size_t)j * SEQ] = to_bf16(lo0[j] * kd); v[(size_t)(4 + j) * SEQ] = to_bf16(lo1[j] * kd);
                                v[(size_t)(128 + j) * SEQ] = to_bf16(hi0[j] * kd); v[(size_t)(132 + j) * SEQ] = to_bf16(hi1[j] * kd); }
                        } else { bf16_t* v = kt + (size_t)4 * 256 * SEQ + (((size_t)(b_ * 4 + head)) * 256 + cw) * 16 + t_;
#pragma unroll
                            for (int j = 0; j < 4; ++j) { v[j * 16] = to_bf16(lo0[j] * kd); v[(4 + j) * 16] = to_bf16(lo1[j] * kd);
                                v[(128 + j) * 16] = to_bf16(hi0[j] * kd); v[(132 + j) * 16] = to_bf16(hi1[j] * kd); }
                        }
                    }
                } else if (seg == 5) {
                    const int head = sub; bf16_t* vt = (bf16_t*)(ws + WS_RVT);
#pragma unroll
                    for (int bj = 0; bj < 2; ++bj) {
                        const f32x4 a = acc[ai][bj][m][0] * r, b = acc[ai][bj][m][1] * r;
                        if (!samp) { bf16_t* v = vt + ((size_t)head * 256 + bj * 128 + cw) * SEQ + row;
#pragma unroll
                            for (int j = 0; j < 4; ++j) { v[(size_t)j * SEQ] = to_bf16(a[j]); v[(size_t)(4 + j) * SEQ] = to_bf16(b[j]); }
                        } else { bf16_t* v = vt + (size_t)4 * 256 * SEQ + (((size_t)(b_ * 4 + head)) * 256 + bj * 128 + cw) * 16 + t_;
#pragma unroll
                            for (int j = 0; j < 4; ++j) { v[j * 16] = to_bf16(a[j]); v[(4 + j) * 16] = to_bf16(b[j]); }
                        }
                    }
                } else {
                    bf16_t* g = (bf16_t*)(ws + WS_G);
#pragma unroll
                    for (int bj = 0; bj < 2; ++bj) {
                        const f32x4 a = acc[ai][bj][m][0] * r, b = acc[ai][bj][m][1] * r;
                        u32x4 w; w.x = pk_bf16(silu_f(a[0]), silu_f(a[1])); w.y = pk_bf16(silu_f(a[2]), silu_f(a[3])); w.z = pk_bf16(silu_f(b[0]), silu_f(b[1])); w.w = pk_bf16(silu_f(b[2]), silu_f(b[3]));
                        *(u32x4*)(g + (size_t)row * 1024 + sub * 256 + bj * 128 + cw) = w;
                    }
                }
                asm volatile("" ::: "memory");
            }
    }
};

#define MFMA32(a, b, c) __builtin_amdgcn_mfma_f32_32x32x16_bf16((a), (b), (c), 0, 0, 0)

DI void tconv_tile(const float* __restrict__ src, int ld, int k0, int n0, const float* __restrict__ gain, bf16_t* __restrict__ dst, int lddst, int drow0, float* tile, int tid) {
    const int r = tid >> 4, c4 = tid & 15;
#pragma unroll
    for (int p = 0; p < 2; ++p) {
        const int k = r + 32 * p;
        f32x4 v = *(const f32x4*)(src + (size_t)(k0 + k) * ld + n0 + c4 * 4);
        if (gain) v *= gain[k0 + k];
        float* t = tile + k * 65 + c4 * 4; t[0] = v[0]; t[1] = v[1]; t[2] = v[2]; t[3] = v[3];
    }
    __syncthreads();
    const int n = tid >> 3, kg = tid & 7;
    const float* t = tile + (kg * 8) * 65 + n;
    u32x4 w; w.x = pk_bf16(t[0], t[65]); w.y = pk_bf16(t[130], t[195]); w.z = pk_bf16(t[260], t[325]); w.w = pk_bf16(t[390], t[455]);
    *(u32x4*)(dst + (size_t)(drow0 + n) * lddst + k0 + kg * 8) = w;
    __syncthreads();
}

struct KP { const float* in[20]; float* out; unsigned char* ws; };

DI void phase0(const KP& p, float* tile, int tid) {
    const int G = gridDim.x, bid = blockIdx.x;
    unsigned char* ws = p.ws;
    constexpr int T_GU = 32 * 88, T_DN = 88 * 32, T_IN = 32 * 112, T_O = 32 * 32, T_ST = 64 * 16;
    constexpr int E0 = T_GU, E1 = E0 + T_GU, E2 = E1 + T_DN, E3 = E2 + T_IN, E4 = E3 + T_O, E5 = E4 + T_GU, E6 = E5 + T_GU, E7 = E6 + T_DN, E8 = E7 + T_ST;
    for (int t = bid; t < E7; t += G) {
        if (t < E1 || (t >= E4 && t < E6)) {
            const bool second = t >= E4; int tt = second ? t - E4 : t; const int up = tt >= T_GU; if (up) tt -= T_GU;
            const int kt = tt / 88, nt = tt % 88, n0 = nt * 64;
            const float* src = p.in[second ? (up ? 17 : 16) : (up ? 7 : 6)];
            tconv_tile(src, DFF, kt * 64, n0, p.in[second ? 15 : 5], (bf16_t*)(ws + (second ? WS_W2T : WS_W1T)), DM, 256 * (n0 >> 7) + 128 * up + (n0 & 127), tile, tid);
        } else if (t < E2 || (t >= E6 && t < E7)) {
            const bool second = t >= E6; const int tt = second ? t - E6 : t - E1; const int kt = tt / 32, nt = tt % 32;
            tconv_tile(p.in[second ? 18 : 8], DM, kt * 64, nt * 64, nullptr, (bf16_t*)(ws + (second ? WS_WD2T : WS_WD1T)), DFF, nt * 64, tile, tid);
        } else if (t < E3) { const int tt = t - E2, kt = tt / 112, nt = tt % 112;
            tconv_tile(p.in[10], DIN, kt * 64, nt * 64, p.in[9], (bf16_t*)(ws + WS_WINT), DM, nt * 64, tile, tid);
        } else { const int tt = t - E3, kt = tt / 32, nt = tt % 32;
            tconv_tile(p.in[14], DM, kt * 64, nt * 64, nullptr, (bf16_t*)(ws + WS_WOT), DM, nt * 64, tile, tid);
        }
    }
    const int lane = tid & 63, wave = tid >> 6, gw = bid * 8 + wave, nw = G * 8;
    float* ssq = (float*)(ws + WS_SSQ); bf16_t* xn = (bf16_t*)(ws + WS_XN);
    for (int row = gw; row < MTOK; row += nw) {
        const float* x = row < SEQ ? p.in[0] + (size_t)row * DM : p.in[1] + (size_t)(row - SEQ) * DM;
        float sq = 0.f;
#pragma unroll
        for (int i = 0; i < 4; ++i) {
            const f32x4 a = *(const f32x4*)(x + i * 512 + lane * 8), b = *(const f32x4*)(x + i * 512 + lane * 8 + 4);
            sq += (a[0] * a[0] + a[1] * a[1]) + (a[2] * a[2] + a[3] * a[3]) + (b[0] * b[0] + b[1] * b[1]) + (b[2] * b[2] + b[3] * b[3]);
            u32x4 w; w.x = pk_bf16(a[0], a[1]); w.y = pk_bf16(a[2], a[3]); w.z = pk_bf16(b[0], b[1]); w.w = pk_bf16(b[2], b[3]);
            *(u32x4*)(xn + (size_t)row * DM + i * 512 + lane * 8) = w;
        }
#pragma unroll
        for (int o = 32; o >= 1; o >>= 1) sq += __shfl_xor(sq, o);
        if (lane == 0) { ssq[row] = sq; ssq[MTOK + row] = 0.f; ssq[2 * MTOK + row] = 0.f; ssq[3 * MTOK + row] = 0.f; }
    }
    float* rope = (float*)(ws + WS_ROPE);
    for (int e = bid * 512 + tid; e < SEQ * 128; e += G * 512) {
        const int pos = e >> 7, i = e & 127;
        const float inv = exp2f(-(float)i * (13.287712379549449f / 128.0f));
        const float ang = (float)pos * inv;
        const double rev = (double)ang * 0.15915494309189535; const float fr = (float)(rev - floor(rev));
        rope[e] = __builtin_amdgcn_cosf(fr); rope[(size_t)SEQ * 128 + e] = __builtin_amdgcn_sinf(fr);
    }
}

struct SbArgs {
    const bf16_t* q; int nq; int qpos0;
    const bf16_t* kA; const bf16_t* vtA; int ldv; int posA0, posA1;
    const float* kC; const float* vC;
    bf16_t* out;
};
DI void sb_unit(const SbArgs& a, int lane) {
    const int r = lane & 31, hl = lane >> 5;
    const int qr = r < a.nq ? r : a.nq - 1;
    bf16x8 qf[8];
#pragma unroll
    for (int ks = 0; ks < 8; ++ks) qf[ks] = *(const bf16x8*)(a.q + (size_t)qr * 128 + ks * 16 + hl * 8);
    const int qpos = a.qpos0 + qr;
    f32x16 o[4];
#pragma unroll
    for (int d = 0; d < 4; ++d)
#pragma unroll
        for (int i = 0; i < 16; ++i) o[d][i] = 0.f;
    float R = 0.f;
    for (int p0 = ((a.qpos0 + a.nq - 1) >> 5) << 5; p0 >= 0; p0 -= 32) {
        f32x16 st;
#pragma unroll
        for (int i = 0; i < 16; ++i) st[i] = 0.f;
        const bool fromA = p0 >= a.posA0;
        if (fromA) {
            int kr = p0 + r; kr = (kr < a.posA1 ? kr : a.posA1 - 1) - a.posA0;
            const bf16_t* kp = a.kA + (size_t)kr * 128 + hl * 8;
#pragma unroll
            for (int ks = 0; ks < 8; ++ks) st = MFMA32(*(const bf16x8*)(kp + ks * 16), qf[ks], st);
        } else {
            const float* kp = a.kC + (size_t)(p0 + r) * 128 + hl * 8;
#pragma unroll
            for (int ks = 0; ks < 8; ++ks) {
                const f32x4 x0 = *(const f32x4*)(kp + ks * 16), x1 = *(const f32x4*)(kp + ks * 16 + 4);
                u32x4 w; w.x = pk_bf16(x0[0], x0[1]); w.y = pk_bf16(x0[2], x0[3]); w.z = pk_bf16(x1[0], x1[1]); w.w = pk_bf16(x1[2], x1[3]);
                st = MFMA32(__builtin_bit_cast(bf16x8, w), qf[ks], st);
                if (ks & 1) asm volatile("" ::: "memory");
            }
        }
        float lk[16], gs[4], og[4], aft[4];
#pragma unroll
        for (int g = 0; g < 4; ++g) {
            gs[g] = 0.f;
#pragma unroll
            for (int e = 0; e < 4; ++e) {
                const int kpos = p0 + 8 * g + 4 * hl + e; const bool valid = kpos < qpos && kpos < a.posA1;
                const float l = valid ? -softplus_f(st[4 * g + e]) : 0.f; lk[4 * g + e] = l; gs[g] += l;
            }
            og[g] = __shfl_xor(gs[g], 32);
        }
        float tot = 0.f;
#pragma unroll
        for (int g = 3; g >= 0; --g) { aft[g] = tot; tot += gs[g] + og[g]; }
#pragma unroll
        for (int g = 0; g < 4; ++g) {
            float run = R + aft[g] + (hl == 0 ? og[g] : 0.f);
#pragma unroll
            for (int e = 3; e >= 0; --e) {
                const int kpos = p0 + 8 * g + 4 * hl + e; const bool valid = kpos < qpos && kpos < a.posA1;
                run += lk[4 * g + e];
                st[4 * g + e] = valid ? __expf(st[4 * g + e] + run) : 0.f;
            }
        }
        R += tot;
#pragma unroll
        for (int s2 = 0; s2 < 2; ++s2) {
            if (p0 + 16 * s2 < a.posA1) {
                u32x4 w; w.x = pk_bf16(st[8 * s2 + 0], st[8 * s2 + 1]); w.y = pk_bf16(st[8 * s2 + 2], st[8 * s2 + 3]); w.z = pk_bf16(st[8 * s2 + 4], st[8 * s2 + 5]); w.w = pk_bf16(st[8 * s2 + 6], st[8 * s2 + 7]);
                const bf16x8 pf = __builtin_bit_cast(bf16x8, w);
#pragma unroll
                for (int dt = 0; dt < 4; ++dt) {
                    const int d = dt * 32 + r; bf16x8 vf;
                    if (fromA) {
                        const bf16_t* vp = a.vtA + (size_t)d * a.ldv + (p0 - a.posA0) + 16 * s2 + 4 * hl;
                        const s16x4 lo = *(const s16x4*)vp, hi = *(const s16x4*)(vp + 8);
                        vf = __builtin_shufflevector(lo, hi, 0, 1, 2, 3, 4, 5, 6, 7);
                    } else {
                        const float* vp = a.vC + (size_t)(p0 + 16 * s2 + 4 * hl) * 128 + d;
                        u32x4 v; v.x = pk_bf16(vp[0], vp[128]); v.y = pk_bf16(vp[256], vp[384]); v.z = pk_bf16(vp[8 * 128], vp[9 * 128]); v.w = pk_bf16(vp[10 * 128], vp[11 * 128]);
                        vf = __builtin_bit_cast(bf16x8, v);
                    }
                    o[dt] = MFMA32(vf, pf, o[dt]);
                    asm volatile("" ::: "memory");
                }
            }
        }
        if (__ballot(R > -110.f) == 0ull) break;
    }
    if (r < a.nq) {
#pragma unroll
        for (int dt = 0; dt < 4; ++dt)
#pragma unroll
            for (int g = 0; g < 4; ++g) {
                u32x2 w; w.x = pk_bf16(o[dt][4 * g], o[dt][4 * g + 1]); w.y = pk_bf16(o[dt][4 * g + 2], o[dt][4 * g + 3]);
                *(u32x2*)(a.out + (size_t)r * DM + dt * 32 + 8 * g + 4 * hl) = w;
            }
    }
}

DI void reta_unit(const KP& p, int item, int w, int lane) {
    const int r = lane & 31, hl = lane >> 5;
    const bool samp = item >= 512;
    const bf16_t* kt = (const bf16_t*)(p.ws + WS_RKDT); const bf16_t* vt = (const bf16_t*)(p.ws + WS_RVT);
    if (!samp) {
        const int h = item >> 7, c = item & 127;
        const bf16_t* ka = kt + ((size_t)h * 256 + w * 32 + r) * SEQ + c * 64 + hl * 8;
        const bf16_t* vb = vt + ((size_t)h * 256 + r) * SEQ + c * 64 + hl * 8;
        bf16x8 A[4];
#pragma unroll
        for (int ks = 0; ks < 4; ++ks) A[ks] = *(const bf16x8*)(ka + ks * 16);
        bf16_t* o = (bf16_t*)(p.ws + WS_KVT) + (size_t)item * 65536;
#pragma unroll 1
        for (int d = 0; d < 8; ++d) {
            f32x16 acc;
#pragma unroll
            for (int i = 0; i < 16; ++i) acc[i] = 0.f;
#pragma unroll
            for (int ks = 0; ks < 4; ++ks) acc = MFMA32(A[ks], *(const bf16x8*)(vb + (size_t)d * 32 * SEQ + ks * 16), acc);
#pragma unroll
            for (int g = 0; g < 4; ++g) {
                u32x2 v; v.x = pk_bf16(acc[4 * g], acc[4 * g + 1]); v.y = pk_bf16(acc[4 * g + 2], acc[4 * g + 3]);
                *(u32x2*)(o + (size_t)(d * 32 + r) * 256 + w * 32 + 8 * g + 4 * hl) = v;
            }
        }
    } else {
        const int it = item - 512, h = it & 3;
        const bf16_t* ka = kt + (size_t)4 * 256 * SEQ + ((size_t)it * 256 + w * 32 + r) * 16 + hl * 8;
        const bf16_t* vb = vt + (size_t)4 * 256 * SEQ + ((size_t)it * 256 + r) * 16 + hl * 8;
        const bf16x8 A = *(const bf16x8*)ka;
        const float cdec = exp2f(log2_gamma(h) * 16.0f);
        const float* s0 = p.in[4] + (size_t)it * 65536; float* o = p.out + O_SS + (size_t)it * 65536;
#pragma unroll 1
        for (int d = 0; d < 8; ++d) {
            f32x16 acc;
#pragma unroll
            for (int i = 0; i < 16; ++i) acc[i] = 0.f;
            acc = MFMA32(A, *(const bf16x8*)(vb + (size_t)d * 32 * 16), acc);
#pragma unroll
            for (int i = 0; i < 16; ++i) {
                const size_t idx = (size_t)(w * 32 + (i & 3) + 8 * (i >> 2) + 4 * hl) * 256 + d * 32 + r;
                o[idx] = cdec * s0[idx] + acc[i];
            }
        }
    }
}

DI void scan_phase(const KP& p, int tid) {
    const bf16_t* kv = (const bf16_t*)(p.ws + WS_KVT); bf16_t* st = (bf16_t*)(p.ws + WS_ST);
    for (int e2 = blockIdx.x * 512 + tid; e2 < 4 * 32768; e2 += gridDim.x * 512) {
        const int h = e2 >> 15, e = (e2 & 32767) * 2;
        const float cdec = exp2f(log2_gamma(h) * 64.0f);
        float s0 = 0.f, s1 = 0.f;
        const size_t base = (size_t)h * 128 * 65536 + e;
#pragma unroll 8
        for (int c = 0; c < 128; ++c) {
            const unsigned kvv = *(const unsigned*)(kv + base + (size_t)c * 65536);
            *(unsigned*)(st + base + (size_t)c * 65536) = pk_bf16(s0, s1);
            s0 = cdec * s0 + __uint_as_float(kvv << 16); s1 = cdec * s1 + __uint_as_float(kvv & 0xffff0000u);
        }
        const int dv = e >> 8, dk = e & 255;
        float* o = p.out + O_SP + (size_t)h * 65536;
        o[(size_t)dk * 256 + dv] = s0; o[(size_t)(dk + 1) * 256 + dv] = s1;
    }
}

struct RcArgs {
    const bf16_t* q; int nq; int i0;
    const bf16_t* k; int nk;
    const bf16_t* vt; int ldv;
    const bf16_t* st;
    float l2g;
    const float* gain;
    const bf16_t* gate;
    bf16_t* out;
};
DI void retc_unit(const RcArgs& a, int lane) {
    const int r = lane & 31, hl = lane >> 5;
    const int qr = r < a.nq ? r : a.nq - 1, qi = a.i0 + qr;
    const bf16_t* qp = a.q + (size_t)qr * 256 + hl * 8;
    f32x16 acc[8];
#pragma unroll
    for (int d = 0; d < 8; ++d)
#pragma unroll
        for (int i = 0; i < 16; ++i) acc[d][i] = 0.f;
#pragma unroll 4
    for (int ks = 0; ks < 16; ++ks) {
        const bf16x8 B = *(const bf16x8*)(qp + ks * 16);
#pragma unroll
        for (int d = 0; d < 8; ++d) acc[d] = MFMA32(*(const bf16x8*)(a.st + (size_t)(d * 32 + r) * 256 + ks * 16 + hl * 8), B, acc[d]);
    }
    const float qdec = exp2f(a.l2g * (float)(qi + 1));
#pragma unroll
    for (int d = 0; d < 8; ++d)
#pragma unroll
        for (int i = 0; i < 16; ++i) acc[d][i] *= qdec;
    const int nblk = (a.i0 + a.nq + 31) >> 5;
    for (int jb = 0; jb < nblk; ++jb) {
        f32x16 st;
#pragma unroll
        for (int i = 0; i < 16; ++i) st[i] = 0.f;
        int kr = jb * 32 + r; kr = kr < a.nk ? kr : a.nk - 1;
        const bf16_t* kp = a.k + (size_t)kr * 256 + hl * 8;
#pragma unroll 4
        for (int ks = 0; ks < 16; ++ks) st = MFMA32(*(const bf16x8*)(kp + ks * 16), *(const bf16x8*)(qp + ks * 16), st);
#pragma unroll
        for (int i = 0; i < 16; ++i) {
            const int j = jb * 32 + (i & 3) + 8 * (i >> 2) + 4 * hl;
            st[i] = (j <= qi && j < a.nk) ? st[i] * exp2f(a.l2g * (float)(qi - j)) : 0.f;
        }
#pragma unroll
        for (int s2 = 0; s2 < 2; ++s2) {
            if (jb * 32 + 16 * s2 < a.nk) {
                u32x4 w; w.x = pk_bf16(st[8 * s2 + 0], st[8 * s2 + 1]); w.y = pk_bf16(st[8 * s2 + 2], st[8 * s2 + 3]); w.z = pk_bf16(st[8 * s2 + 4], st[8 * s2 + 5]); w.w = pk_bf16(st[8 * s2 + 6], st[8 * s2 + 7]);
                const bf16x8 pf = __builtin_bit_cast(bf16x8, w);
#pragma unroll
                for (int d = 0; d < 8; ++d) {
                    const bf16_t* vp = a.vt + (size_t)(d * 32 + r) * a.ldv + jb * 32 + 16 * s2 + 4 * hl;
                    const s16x4 lo = *(const s16x4*)vp, hi = *(const s16x4*)(vp + 8);
                    acc[d] = MFMA32(__builtin_shufflevector(lo, hi, 0, 1, 2, 3, 4, 5, 6, 7), pf, acc[d]);
                }
            }
        }
    }
    float ss = 0.f;
#pragma unroll
    for (int d = 0; d < 8; ++d)
#pragma unroll
        for (int i = 0; i < 16; ++i) ss += acc[d][i] * acc[d][i];
    ss += __shfl_xor(ss, 32);
    const float rs = rsqrtf(ss * (1.0f / 256.0f) + EPS);
    if (r < a.nq) {
#pragma unroll
        for (int d = 0; d < 8; ++d)
#pragma unroll
            for (int g = 0; g < 4; ++g) {
                const int dv = d * 32 + 8 * g + 4 * hl;
                const f32x4 gn = *(const f32x4*)(a.gain + dv);
                const u32x2 gt = *(const u32x2*)(a.gate + (size_t)r * 1024 + dv);
                const float g0 = __uint_as_float(gt.x << 16), g1 = __uint_as_float(gt.x & 0xffff0000u), g2 = __uint_as_float(gt.y << 16), g3 = __uint_as_float(gt.y & 0xffff0000u);
                u32x2 w; w.x = pk_bf16(acc[d][4 * g] * rs * gn[0] * g0, acc[d][4 * g + 1] * rs * gn[1] * g1); w.y = pk_bf16(acc[d][4 * g + 2] * rs * gn[2] * g2, acc[d][4 * g + 3] * rs * gn[3] * g3);
                *(u32x2*)(a.out + (size_t)r * DM + dv) = w;
            }
    }
}

constexpr int LDS_BYTES = pg8::STAGE_BYTES + 8192;
__global__ void __launch_bounds__(512, 2) fwd_kernel(KP p) {
    extern __shared__ __attribute__((aligned(16))) unsigned char lds[];
    cg::grid_group grid = cg::this_grid();
    const int tid = threadIdx.x, lane = tid & 63, wave = __builtin_amdgcn_readfirstlane(tid >> 6);
    const int G = gridDim.x, bid = blockIdx.x;
    unsigned char* ws = p.ws;
    PG8_LAS unsigned char* l3 = (PG8_LAS unsigned char*)lds;
    float* ssq = (float*)(ws + WS_SSQ);
    bf16_t* XN = (bf16_t*)(ws + WS_XN); bf16_t* H = (bf16_t*)(ws + WS_H); float* X1 = (float*)(ws + WS_X1); bf16_t* MIX = (bf16_t*)(ws + WS_MIX);

    phase0(p, (float*)lds, tid);
    grid.sync();
    {
        pg8::Gemm g{XN, (const bf16_t*)(ws + WS_W1T), MTOK, 2 * DFF, DM}; pg8::StaticOrder S; S.init(MTOK, 2 * DFF, G, bid);
        EpiSwiglu E{H, ssq};
        pg8::gemm_phase<EpiSwiglu, pg8::StaticOrder>(l3, g, S, E, nullptr);
    }
    grid.sync();
    {
        pg8::Gemm g{H, (const bf16_t*)(ws + WS_WD1T), MTOK, DM, DFF}; pg8::StaticOrder S; S.init(MTOK, DM, G, bid);
        EpiResid E{p.in[0], p.in[1], X1, XN, ssq + MTOK, 0.5f};
        pg8::gemm_phase<EpiResid, pg8::StaticOrder>(l3, g, S, E, nullptr);
    }
    grid.sync();
    {
        pg8::Gemm g{XN, (const bf16_t*)(ws + WS_WINT), MTOK, DIN, DM}; pg8::StaticOrder S; S.init(MTOK, DIN, G, bid);
        EpiIn E{ssq + MTOK, p.in[11], p.in[12], (const float*)(ws + WS_ROPE), p.out, ws, (float*)(lds + pg8::STAGE_BYTES)};
        pg8::gemm_phase<EpiIn, pg8::StaticOrder>(l3, g, S, E, nullptr);
    }
    grid.sync();
    {
        for (int tt = bid; tt < 1024; tt += G) {
            const int it = tt >> 4, kt = (tt >> 2) & 3, nt = tt & 3;
            tconv_tile(p.in[4] + (size_t)it * 65536, 256, kt * 64, nt * 64, nullptr, (bf16_t*)(ws + WS_ST) + (size_t)(512 + it) * 65536, 256, nt * 64, (float*)lds, tid);
        }
        const int gw = bid * 8 + wave, nw = G * 8;
        constexpr int U_RA = 576 * 8, U_SBP = 8 * 256, U_SBS = 128;
        for (int u = gw; u < U_RA + U_SBP + U_SBS; u += nw) {
            if (u < U_RA) reta_unit(p, u >> 3, u & 7, lane);
            else if (u < U_RA + U_SBP) {
                const int v = u - U_RA, h = v >> 8, qb = 255 - (v & 255);
                SbArgs a; a.q = (const bf16_t*)(ws + WS_QB) + ((size_t)h * SEQ + qb * 32) * 128; a.nq = 32; a.qpos0 = qb * 32;
                a.kA = (const bf16_t*)(ws + WS_KB) + (size_t)h * SEQ * 128; a.vtA = (const bf16_t*)(ws + WS_VT) + (size_t)h * 128 * SEQ; a.ldv = SEQ; a.posA0 = 0; a.posA1 = SEQ;
                a.kC = nullptr; a.vC = nullptr; a.out = MIX + (size_t)(qb * 32) * DM + h * 128;
                sb_unit(a, lane);
            } else {
                const int bh = u - U_RA - U_SBP, b = bh >> 3, h = bh & 7;
                SbArgs a; a.q = (const bf16_t*)(ws + WS_QB) + (size_t)8 * SEQ * 128 + (size_t)bh * 16 * 128; a.nq = 16; a.qpos0 = PAST;
                a.kA = (const bf16_t*)(ws + WS_KB) + (size_t)8 * SEQ * 128 + (size_t)bh * 16 * 128; a.vtA = (const bf16_t*)(ws + WS_VT) + (size_t)8 * 128 * SEQ + (size_t)bh * 128 * 16; a.ldv = 16; a.posA0 = PAST; a.posA1 = PAST + DECS;
                a.kC = p.in[2] + (size_t)bh * PAST * 128; a.vC = p.in[3] + (size_t)bh * PAST * 128; a.out = MIX + (size_t)(SEQ + b * 16) * DM + h * 128;
                sb_unit(a, lane);
            }
        }
    }
    grid.sync();
    scan_phase(p, tid);
    grid.sync();
    {
        const int gw = bid * 8 + wave, nw = G * 8;
        for (int u = gw; u < 1024 + 64; u += nw) {
            RcArgs a;
            if (u < 1024) {
                const int item = u >> 1, half = u & 1, h = item >> 7, c = item & 127, tok = c * 64 + half * 32;
                a.q = (const bf16_t*)(ws + WS_RQ) + ((size_t)h * SEQ + tok) * 256; a.nq = 32; a.i0 = half * 32;
                a.k = (const bf16_t*)(ws + WS_RK) + ((size_t)h * SEQ + c * 64) * 256; a.nk = 64;
                a.vt = (const bf16_t*)(ws + WS_RVT) + (size_t)h * 256 * SEQ + c * 64; a.ldv = SEQ;
                a.st = (const bf16_t*)(ws + WS_ST) + (size_t)item * 65536; a.l2g = log2_gamma(h); a.gain = p.in[13] + h * 256;
                a.gate = (const bf16_t*)(ws + WS_G) + (size_t)tok * 1024 + h * 256; a.out = MIX + (size_t)tok * DM + 1024 + h * 256;
            } else {
                const int it = u - 1024, b = it >> 2, h = it & 3, row = SEQ + b * 16;
                a.q = (const bf16_t*)(ws + WS_RQ) + (size_t)4 * SEQ * 256 + (size_t)it * 16 * 256; a.nq = 16; a.i0 = 0;
                a.k = (const bf16_t*)(ws + WS_RK) + (size_t)4 * SEQ * 256 + (size_t)it * 16 * 256; a.nk = 16;
                a.vt = (const bf16_t*)(ws + WS_RVT) + (size_t)4 * 256 * SEQ + (size_t)it * 256 * 16; a.ldv = 16;
                a.st = (const bf16_t*)(ws + WS_ST) + (size_t)(512 + it) * 65536; a.l2g = log2_gamma(h); a.gain = p.in[13] + h * 256;
                a.gate = (const bf16_t*)(ws + WS_G) + (size_t)row * 1024 + h * 256; a.out = MIX + (size_t)row * DM + 1024 + h * 256;
            }
            retc_unit(a, lane);
        }
    }
    grid.sync();
    {
        pg8::Gemm g{MIX, (const bf16_t*)(ws + WS_WOT), MTOK, DM, DM}; pg8::StaticOrder S; S.init(MTOK, DM, G, bid);
        EpiResid E{X1, X1 + (size_t)SEQ * DM, X1, XN, ssq + 2 * MTOK, 1.0f};
        pg8::gemm_phase<EpiResid, pg8::StaticOrder>(l3, g, S, E, nullptr);
    }
    grid.sync();
    {
        pg8::Gemm g{XN, (const bf16_t*)(ws + WS_W2T), MTOK, 2 * DFF, DM}; pg8::StaticOrder S; S.init(MTOK, 2 * DFF, G, bid);
        EpiSwiglu E{H, ssq + 2 * MTOK};
        pg8::gemm_phase<EpiSwiglu, pg8::StaticOrder>(l3, g, S, E, nullptr);
    }
    grid.sync();
    {
        pg8::Gemm g{H, (const bf16_t*)(ws + WS_WD2T), MTOK, DM, DFF}; pg8::StaticOrder S; S.init(MTOK, DM, G, bid);
        EpiResid E{X1, X1 + (size_t)SEQ * DM, X1, XN, ssq + 3 * MTOK, 0.5f};
        pg8::gemm_phase<EpiResid, pg8::StaticOrder>(l3, g, S, E, nullptr);
    }
    grid.sync();
    {
        const int gw = bid * 8 + wave, nw = G * 8; const float* fn = p.in[19];
        for (int row = gw; row < MTOK; row += nw) {
            const float rs = rsqrtf(ssq[3 * MTOK + row] * (1.0f / DM) + EPS);
            const float* x = X1 + (size_t)row * DM; float* y = p.out + O_Y + (size_t)row * DM;
#pragma unroll
            for (int i = 0; i < 8; ++i) { const int c = i * 256 + lane * 4; *(f32x4*)(y + c) = *(const f32x4*)(x + c) * rs * *(const f32x4*)(fn + c); }
        }
    }
}

extern "C" void kernel_launch(void* const* d_in, const int* in_sizes, int n_in, void* d_out, int out_size, void* d_ws, size_t ws_size, hipStream_t stream) {
    static int grid_blocks = 0;
    if (!grid_blocks) {
        if (n_in != 20 || ws_size < WS_END) { fprintf(stderr, "kernel_launch: need 20 inputs and %zu bytes of workspace (got %d, %zu)\n", (size_t)WS_END, n_in, ws_size); grid_blocks = -1; return; }
        int dev = 0, cus = 0, per_cu = 0;
        hipGetDevice(&dev);
        hipDeviceGetAttribute(&cus, hipDeviceAttributeMultiprocessorCount, dev);
        hipFuncSetAttribute((const void*)fwd_kernel, hipFuncAttributeMaxDynamicSharedMemorySize, LDS_BYTES);
        hipOccupancyMaxActiveBlocksPerMultiprocessor(&per_cu, (const void*)fwd_kernel, 512, LDS_BYTES);
        if (per_cu < 1) { fprintf(stderr, "kernel_launch: occupancy query says %d blocks per CU\n", per_cu); per_cu = 1; }
        grid_blocks = cus;
    }
    if (grid_blocks < 0) return;
    KP p{};
    for (int i = 0; i < 20; ++i) p.in[i] = (const float*)d_in[i];
    p.out = (float*)d_out; p.ws = (unsigned char*)d_ws;
    void* args[] = {&p};
    hipError_t e = hipLaunchCooperativeKernel((const void*)fwd_kernel, dim3(grid_blocks), dim3(512), args, LDS_BYTES, stream);
    if (e != hipSuccess) fprintf(stderr, "cooperative launch failed: %s (grid %d)\n", hipGetErrorString(e), grid_blocks);
}
```

```cpp
#include <hip/hip_runtime.h>
#include <hip/hip_cooperative_groups.h>
#include <cstdio>
namespace cg = cooperative_groups;

#define DI __device__ __forceinline__
typedef unsigned short bf16_t;
typedef short bf16x8 __attribute__((ext_vector_type(8)));
typedef short s16x4 __attribute__((ext_vector_type(4)));
typedef float f32x4 __attribute__((ext_vector_type(4)));
typedef float f32x2 __attribute__((ext_vector_type(2)));
typedef float f32x16 __attribute__((ext_vector_type(16)));
typedef unsigned u32x4 __attribute__((ext_vector_type(4)));
typedef unsigned u32x2 __attribute__((ext_vector_type(2)));

constexpr int DM = 2048, SEQ = 8192, NSAMP = 256, MTOK = SEQ + NSAMP, DFF = 5632, DIN = 7168, PAST = 2048, DECS = 16, DECB = 16;
constexpr float EPS = 1e-6f;

constexpr size_t al256(size_t x) { return (x + 255) & ~(size_t)255; }
constexpr size_t WS_W1T = 0;
constexpr size_t WS_WD1T = WS_W1T + (size_t)2 * DFF * DM * 2;
constexpr size_t WS_WINT = WS_WD1T + (size_t)DM * DFF * 2;
constexpr size_t WS_WOT = WS_WINT + (size_t)DIN * DM * 2;
constexpr size_t WS_W2T = WS_WOT + (size_t)DM * DM * 2;
constexpr size_t WS_WD2T = WS_W2T + (size_t)2 * DFF * DM * 2;
constexpr size_t WS_XN = WS_WD2T + (size_t)DM * DFF * 2;
constexpr size_t WS_H = WS_XN + (size_t)MTOK * DM * 2;
constexpr size_t WS_ST = WS_H;
constexpr size_t WS_X1 = WS_H + (size_t)MTOK * DFF * 2;
constexpr size_t WS_SSQ = WS_X1 + (size_t)MTOK * DM * 4;
constexpr size_t WS_QB = al256(WS_SSQ + (size_t)4 * MTOK * 4);
constexpr size_t SEG_B = (size_t)MTOK * 1024 * 2;
constexpr size_t WS_KB = WS_QB + SEG_B;
constexpr size_t WS_VT = WS_KB + SEG_B;
constexpr size_t WS_RQ = WS_VT + SEG_B;
constexpr size_t WS_RK = WS_RQ + SEG_B;
constexpr size_t WS_RKDT = WS_RK + SEG_B;
constexpr size_t WS_RVT = WS_RKDT + SEG_B;
constexpr size_t WS_G = WS_RVT + SEG_B;
constexpr size_t WS_MIX = WS_G + SEG_B;
constexpr size_t WS_KVT = WS_MIX + (size_t)MTOK * DM * 2;
constexpr size_t WS_ROPE = WS_KVT + (size_t)512 * 65536 * 2;
constexpr size_t WS_END = WS_ROPE + (size_t)2 * SEQ * 128 * 4;
static_assert((size_t)576 * 65536 * 2 <= (size_t)MTOK * DFF * 2, "ST must fit in H");

constexpr size_t O_Y = 0;
constexpr size_t O_KP = (size_t)MTOK * DM;
constexpr size_t O_VP = O_KP + (size_t)8 * SEQ * 128;
constexpr size_t O_SP = O_VP + (size_t)8 * SEQ * 128;
constexpr size_t O_KS = O_SP + (size_t)4 * 65536;
constexpr size_t O_VS = O_KS + (size_t)DECB * 8 * DECS * 128;
constexpr size_t O_SS = O_VS + (size_t)DECB * 8 * DECS * 128;

DI unsigned pk_bf16(float a, float b) {
    typedef __bf16 bf2 __attribute__((ext_vector_type(2)));
    bf2 v; v[0] = (__bf16)a; v[1] = (__bf16)b; return __builtin_bit_cast(unsigned, v);
}
DI bf16_t to_bf16(float a) { return __builtin_bit_cast(bf16_t, (__bf16)a); }
DI float silu_f(float g) { return g * __builtin_amdgcn_rcpf(1.f + __expf(-g)); }
DI float softplus_f(float z) { return fmaxf(z, 0.f) + __logf(1.f + __expf(-fabsf(z))); }
DI float log2_gamma(int h) { return __log2f(1.0f - exp2f(-5.0f - (float)h)); }

namespace pg8 {
#define PG8_LAS __attribute__((address_space(3)))
typedef unsigned short bf16_t;
typedef short bf16x8 __attribute__((ext_vector_type(8)));
typedef float f32x4 __attribute__((ext_vector_type(4)));
typedef unsigned u32x4 __attribute__((ext_vector_type(4)));
constexpr int BM = 256, BK = 64, HALF = 128, HTB = HALF * BK * 2  , STAGE_BYTES = 8 * HTB, NXCD = 8, WGM = 8;

__host__ __device__ __forceinline__ int lds_byte(int r, int c) { const int st = (r >> 4) * 2 + (c >> 5), rr = r & 15, cc = c & 31, ob = rr * 64 + cc * 2; return st * 1024 + (ob ^ (((ob >> 9) & 1) << 5)); }
__host__ __device__ __forceinline__ void stage_rc(int b, int& R, int& C) { const int st = b / 1024, sb = b % 1024, swz = sb ^ (((sb >> 9) & 1) << 5); R = (st >> 1) * 16 + swz / 64; C = (st & 1) * 32 + (swz % 64) / 2; }
__host__ __device__ __forceinline__ int perm32(int rho) { const int n = rho >> 4, i = rho & 15; return 8 * (i >> 2) + 4 * n + (i & 3); }

struct Unit { int pm, pn; };
struct Gemm { const bf16_t* A; const bf16_t* Bt; int M, N, K; };

struct StaticOrder {
    int nM, nN, nwg, G, c;
    __host__ __device__ void init(int M, int N, int G_, int c_) { nM = M / BM; nN = N / BM; nwg = nM * nN; G = G_; c = c_; }
    __host__ __device__ bool next(int i, Unit& u) const {
        const long L = (long)i * G + c; if (L >= nwg) return false;
        int wgid = (int)L; { const int q = nwg / NXCD, r = nwg % NXCD, xcd = wgid % NXCD, off = wgid / NXCD; wgid = (xcd < r ? xcd * (q + 1) : r * (q + 1) + (xcd - r) * q) + off; }
        const int nig = WGM * nN, gid = wgid / nig, fm = gid * WGM, gsz = (nM - fm) < WGM ? (nM - fm) : WGM;
        u.pm = fm + ((wgid % nig) % gsz); u.pn = (wgid % nig) / gsz; return true;
    }
    __device__ __forceinline__ void a_ready(const Unit&) const {}
    __device__ __forceinline__ void done(const Unit&) const {}
};
template <class Epi, class Sched, bool STAMP = false>
__device__ __forceinline__ void gemm_phase(PG8_LAS unsigned char* lds, const Gemm g, const Sched& S, const Epi& E, unsigned long long* stamps) {
    int tid_ = threadIdx.x; asm volatile("" : "+v"(tid_));
    const int tid = tid_, wid = __builtin_amdgcn_readfirstlane(tid >> 6), lane = tid & 63, wr = wid >> 2, wc = wid & 3, fr = lane & 15, fq = lane >> 4;
    const int K = g.K, nt = K / BK;
    int ts_lo = 0, ts_hi = 0, nts = 0; const unsigned long long rt_entry = STAMP ? (unsigned long long)wall_clock64() : 0ull;
#define PG8_STAMP() do { if (STAMP && wid == 0 && nts < 64) { const unsigned long long _c = (unsigned long long)clock64(); \
        ts_lo = (lane == nts) ? (int)(unsigned)_c : ts_lo; ts_hi = (lane == nts) ? (int)(unsigned)(_c >> 32) : ts_hi; ++nts; } } while (0)
    PG8_STAMP();
    unsigned voffA[2], voffB[2];
#pragma unroll
    for (int i = 0; i < 2; ++i) { int R, C; stage_rc(tid * 16 + i * 8192, R, C); const int Rb = Epi::PERM ? ((R & ~31) + perm32(R & 31)) : R;
        voffA[i] = (unsigned)(R * K + C) * 2u; voffB[i] = (unsigned)(Rb * K + C) * 2u; }
    const size_t kstep = (size_t)(BK * 2);
    const size_t hstep = (size_t)HALF * K * 2;
    const size_t tstep = 2 * hstep;
    const unsigned ldsw = (unsigned)wid * 1024u;
    const int aoff = lds_byte(wr * 64 + fr, fq * 8), boff = lds_byte(wc * 32 + fr, fq * 8);
#define PG8_SA(b, h) (((b) * 2 + (h)) * HTB)
#define PG8_SB(b, h) ((4 + (b) * 2 + (h)) * HTB)
#define PG8_STAGE(bufoff, gbase, voff) do { _Pragma("unroll") for (int _i = 0; _i < 2; ++_i) \
        __builtin_amdgcn_global_load_lds((const unsigned*)((const char*)(gbase) + (voff)[_i]), (PG8_LAS unsigned*)(lds + (bufoff) + ldsw + _i * 8192), 16, 0, 0); } while (0)
#define PG8_LDA(dst, b, h) do { _Pragma("unroll") for (int m = 0; m < 4; ++m) _Pragma("unroll") for (int k = 0; k < 2; ++k) dst[m][k] = *(const PG8_LAS bf16x8*)(lds + PG8_SA(b, h) + aoff + m * 2048 + k * 1024); } while (0)
#define PG8_LDB(dst, b, h) do { _Pragma("unroll") for (int n = 0; n < 2; ++n) _Pragma("unroll") for (int k = 0; k < 2; ++k) dst[n][k] = *(const PG8_LAS bf16x8*)(lds + PG8_SB(b, h) + boff + n * 2048 + k * 1024); } while (0)
#define PG8_MMA(ai, bj, At, Bt) do { __builtin_amdgcn_s_setprio(1); _Pragma("unroll") for (int m = 0; m < 4; ++m) _Pragma("unroll") for (int n = 0; n < 2; ++n) _Pragma("unroll") for (int k = 0; k < 2; ++k) \
        acc[ai][bj][m][n] = __builtin_amdgcn_mfma_f32_16x16x32_bf16(Bt[n][k], At[m][k], acc[ai][bj][m][n], 0, 0, 0); __builtin_amdgcn_s_setprio(0); } while (0)
#define PG8_WAIT_V(n) asm volatile("s_waitcnt vmcnt(" #n ")" ::: "memory")
#define PG8_WAIT_L(n) asm volatile("s_waitcnt lgkmcnt(" #n ")" ::: "memory")
#define PG8_BAR __builtin_amdgcn_s_barrier()
#define PG8_SCHED __builtin_amdgcn_sched_barrier(0)
    Unit cur, nxt; int ui = 0;
    if (!S.next(0, cur)) return;
    f32x4 acc[2][2][4][2];
#pragma unroll
    for (int a = 0; a < 2; ++a)
#pragma unroll
        for (int b = 0; b < 2; ++b)
#pragma unroll
            for (int m = 0; m < 4; ++m)
#pragma unroll
                for (int n = 0; n < 2; ++n) acc[a][b][m][n] = (f32x4){0.f, 0.f, 0.f, 0.f};
    bf16x8 At[4][2], B0[2][2], B1[2][2];
    const char* cA = (const char*)g.A + (size_t)cur.pm * tstep; const char* cB = (const char*)g.Bt + (size_t)cur.pn * tstep;
    S.a_ready(cur);
    PG8_STAGE(PG8_SB(0, 0), cB, voffB); PG8_STAGE(PG8_SA(0, 0), cA, voffA); PG8_STAGE(PG8_SB(0, 1), cB + hstep, voffB); PG8_STAGE(PG8_SA(0, 1), cA + hstep, voffA);
    if (wr == 1) PG8_BAR;
    PG8_WAIT_V(4); PG8_BAR;
    PG8_STAGE(PG8_SB(1, 0), cB + kstep, voffB); PG8_STAGE(PG8_SA(1, 0), cA + kstep, voffA); PG8_STAGE(PG8_SB(1, 1), cB + hstep + kstep, voffB);
    PG8_WAIT_V(6); PG8_BAR;
    PG8_STAMP();
    for (;;) {
        const bool has_next = S.next(ui + 1, nxt);
        const char* nA = has_next ? (const char*)g.A + (size_t)nxt.pm * tstep : cA; const char* nB = has_next ? (const char*)g.Bt + (size_t)nxt.pn * tstep : cB;
        for (int t = 0; t < nt; t += 2) {
            const bool last = (t == nt - 2);
            const char* a1 = cA + (size_t)(t + 1) * kstep;
            const char* a2 = last ? nA : cA + (size_t)(t + 2) * kstep; const char* b2 = last ? nB : cB + (size_t)(t + 2) * kstep;
            const char* a3 = a2 + kstep; const char* b3 = b2 + kstep;
            if (last && has_next) S.a_ready(nxt);
            PG8_LDB(B0, 0, 0); PG8_SCHED; PG8_LDA(At, 0, 0); PG8_STAGE(PG8_SA(1, 1), a1 + hstep, voffA);
            PG8_WAIT_L(8); PG8_BAR; PG8_WAIT_L(0); PG8_MMA(0, 0, At, B0); PG8_BAR; PG8_SCHED;
            PG8_LDB(B1, 0, 1); PG8_STAGE(PG8_SB(0, 0), b2, voffB);
            PG8_BAR; PG8_WAIT_L(0); PG8_MMA(0, 1, At, B1); PG8_BAR;
            PG8_LDA(At, 0, 1); PG8_STAGE(PG8_SA(0, 0), a2, voffA);
            PG8_BAR; PG8_WAIT_L(0); PG8_MMA(1, 0, At, B0); PG8_BAR; PG8_SCHED;
            PG8_STAGE(PG8_SB(0, 1), b2 + hstep, voffB);
            PG8_WAIT_V(6); PG8_BAR; PG8_MMA(1, 1, At, B1); PG8_BAR;
            PG8_LDB(B0, 1, 0); PG8_SCHED; PG8_LDA(At, 1, 0); PG8_STAGE(PG8_SA(0, 1), a2 + hstep, voffA);
            PG8_WAIT_L(8); PG8_BAR; PG8_WAIT_L(0); PG8_MMA(0, 0, At, B0); PG8_BAR; PG8_SCHED;
            PG8_LDB(B1, 1, 1); PG8_STAGE(PG8_SB(1, 0), b3, voffB);
            PG8_BAR; PG8_WAIT_L(0); PG8_MMA(0, 1, At, B1); PG8_BAR;
            PG8_LDA(At, 1, 1); PG8_STAGE(PG8_SA(1, 0), a3, voffA);
            PG8_BAR; PG8_WAIT_L(0); PG8_MMA(1, 0, At, B0); PG8_BAR; PG8_SCHED;
            PG8_STAGE(PG8_SB(1, 1), b3 + hstep, voffB);
            PG8_WAIT_V(6); PG8_BAR; PG8_MMA(1, 1, At, B1); PG8_BAR;
        }
        PG8_STAMP();
        if constexpr (!Epi::AFTER_DRAIN) { E(acc, cur, wr, wc, fr, fq); S.done(cur); }
        PG8_STAMP();
        if (!has_next) break;
#pragma unroll
        for (int a = 0; a < 2; ++a)
#pragma unroll
            for (int b = 0; b < 2; ++b)
#pragma unroll
                for (int m = 0; m < 4; ++m)
#pragma unroll
                    for (int n = 0; n < 2; ++n) acc[a][b][m][n] = (f32x4){0.f, 0.f, 0.f, 0.f};
        cur = nxt; cA = nA; cB = nB; ++ui;
    }
    PG8_WAIT_V(0);
    if (wr == 0) PG8_BAR;
    PG8_BAR;
    if constexpr (Epi::AFTER_DRAIN) { E.fused(acc, cur, wr, wc, fr, fq, lds, wid, lane); S.done(cur); }
    PG8_STAMP();
    if (STAMP && wid == 0) { stamps[lane] = lane < nts ? (((unsigned long long)(unsigned)ts_hi << 32) | (unsigned)ts_lo) : 0ull;
        if (lane == 62) stamps[62] = rt_entry; if (lane == 63) stamps[63] = (unsigned long long)wall_clock64(); }
#undef PG8_STAMP
#undef PG8_SA
#undef PG8_SB
#undef PG8_STAGE
#undef PG8_LDA
#undef PG8_LDB
#undef PG8_MMA
#undef PG8_WAIT_V
#undef PG8_WAIT_L
#undef PG8_BAR
#undef PG8_SCHED
}
}

using pg8::Unit;
typedef f32x4 AccT[2][2][4][2];

struct EpiSwiglu {
    static constexpr bool PERM = true, AFTER_DRAIN = false;
    bf16_t* H; const float* ssq;
    DI void operator()(const AccT& acc, const Unit& u, int wr, int wc, int fr_, int fq_) const {
        int fr = fr_, fq = fq_; asm volatile("" : "+v"(fr), "+v"(fq));
        const int row0 = u.pm * 256 + wr * 64 + fr, col0 = u.pn * 128 + wc * 32 + 8 * fq;
#pragma unroll
        for (int ai = 0; ai < 2; ++ai)
#pragma unroll
            for (int m = 0; m < 4; ++m) {
                const int row = row0 + ai * 128 + m * 16;
                const float r = rsqrtf(ssq[row] * (1.0f / DM) + EPS);
                float hv[8];
#pragma unroll
                for (int n = 0; n < 2; ++n)
#pragma unroll
                    for (int j = 0; j < 4; ++j) { const float g = acc[ai][0][m][n][j] * r, up = acc[ai][1][m][n][j] * r; hv[n * 4 + j] = silu_f(g) * up; }
                u32x4 w; w.x = pk_bf16(hv[0], hv[1]); w.y = pk_bf16(hv[2], hv[3]); w.z = pk_bf16(hv[4], hv[5]); w.w = pk_bf16(hv[6], hv[7]);
                *(u32x4*)(H + (size_t)row * DFF + col0) = w;
            }
    }
};

struct EpiResid {
    static constexpr bool PERM = true, AFTER_DRAIN = false;
    const float* xa; const float* xs; float* xo; bf16_t* xb; float* ssq; float scale;
    DI void operator()(const AccT& acc, const Unit& u, int wr, int wc, int fr_, int fq_) const {
        int fr = fr_, fq = fq_; asm volatile("" : "+v"(fr), "+v"(fq));
        const int row0 = u.pm * 256 + wr * 64 + fr, col0 = u.pn * 256 + wc * 32 + 8 * fq;
        const float* src = (u.pm == 32) ? xs - (size_t)SEQ * DM : xa;
#pragma unroll
        for (int ai = 0; ai < 2; ++ai)
#pragma unroll
            for (int m = 0; m < 4; ++m) {
                const int row = row0 + ai * 128 + m * 16;
                float sq = 0.f;
#pragma unroll
                for (int bj = 0; bj < 2; ++bj) {
                    const size_t off = (size_t)row * DM + col0 + bj * 128;
                    const f32x4 x0 = *(const f32x4*)(src + off), x1 = *(const f32x4*)(src + off + 4);
                    const f32x4 y0 = x0 + acc[ai][bj][m][0] * scale, y1 = x1 + acc[ai][bj][m][1] * scale;
                    *(f32x4*)(xo + off) = y0; *(f32x4*)(xo + off + 4) = y1;
                    u32x4 w; w.x = pk_bf16(y0[0], y0[1]); w.y = pk_bf16(y0[2], y0[3]); w.z = pk_bf16(y1[0], y1[1]); w.w = pk_bf16(y1[2], y1[3]);
                    *(u32x4*)(xb + off) = w;
                    sq += (y0[0] * y0[0] + y0[1] * y0[1]) + (y0[2] * y0[2] + y0[3] * y0[3]) + (y1[0] * y1[0] + y1[1] * y1[1]) + (y1[2] * y1[2] + y1[3] * y1[3]);
                }
                sq += __shfl_xor(sq, 16); sq += __shfl_xor(sq, 32);
                if (fq == 0) atomicAdd(ssq + row, sq);
                asm volatile("" ::: "memory");
            }
    }
};

struct EpiIn {
    static constexpr bool PERM = true, AFTER_DRAIN = false;
    const float* ssq; const float* qn; const float* kn; const float* rope; float* out; unsigned char* ws; float* tbl  ;
    DI void operator()(const AccT& acc, const Unit& u, int wr, int wc, int fr_, int fq_) const {
        int fr = fr_, fq = fq_; asm volatile("" : "+v"(fr), "+v"(fq));
        const int seg = u.pn >> 2, sub = u.pn & 3;
        const bool samp = (u.pm == 32);
        const int rl0 = wr * 64 + fr;
        const int cw = wc * 32 + 8 * fq;
        if (seg <= 1) {
            float rr[2][4];
#pragma unroll
            for (int ai = 0; ai < 2; ++ai)
#pragma unroll
                for (int m = 0; m < 4; ++m) {
                    const int rl = rl0 + ai * 128 + m * 16;
                    const float r = rsqrtf(ssq[u.pm * 256 + rl] * (1.0f / DM) + EPS); rr[ai][m] = r;
#pragma unroll
                    for (int bj = 0; bj < 2; ++bj) {
                        const f32x4 a = acc[ai][bj][m][0] * r, b = acc[ai][bj][m][1] * r;
                        float s = (a[0] * a[0] + a[1] * a[1]) + (a[2] * a[2] + a[3] * a[3]) + (b[0] * b[0] + b[1] * b[1]) + (b[2] * b[2] + b[3] * b[3]);
                        s += __shfl_xor(s, 16); s += __shfl_xor(s, 32);
                        if (fq == 0) tbl[(rl * 2 + bj) * 4 + wc] = s;
                    }
                }
            asm volatile("s_waitcnt lgkmcnt(0)" ::: "memory"); __builtin_amdgcn_s_barrier(); asm volatile("" ::: "memory");
            const float* gn = seg == 0 ? qn : kn;
            const float post = seg == 0 ? 0.08838834764831845f : 1.0f;
            f32x4 g0 = *(const f32x4*)(gn + cw), g1 = *(const f32x4*)(gn + cw + 4);
            g0 *= post; g1 *= post;
            bf16_t* dstb = (bf16_t*)(ws + (seg == 0 ? WS_QB : WS_KB));
#pragma unroll
            for (int ai = 0; ai < 2; ++ai)
#pragma unroll
                for (int m = 0; m < 4; ++m) {
                    const int rl = rl0 + ai * 128 + m * 16;
#pragma unroll
                    for (int bj = 0; bj < 2; ++bj) {
                        const f32x4 t = *(const f32x4*)(tbl + (rl * 2 + bj) * 4);
                        const float hr = rsqrtf(((t[0] + t[1]) + (t[2] + t[3])) * (1.0f / 128.0f) + EPS) * rr[ai][m];
                        const f32x4 a = acc[ai][bj][m][0] * hr * g0, b = acc[ai][bj][m][1] * hr * g1;
                        const int head = sub * 2 + bj;
                        size_t idx;
                        if (!samp) idx = ((size_t)head * SEQ + (u.pm * 256 + rl)) * 128 + cw;
                        else { const int sr = rl, b_ = sr >> 4, t_ = sr & 15; idx = (size_t)8 * SEQ * 128 + (((size_t)(b_ * 8 + head)) * 16 + t_) * 128 + cw; }
                        u32x4 w; w.x = pk_bf16(a[0], a[1]); w.y = pk_bf16(a[2], a[3]); w.z = pk_bf16(b[0], b[1]); w.w = pk_bf16(b[2], b[3]);
                        *(u32x4*)(dstb + idx) = w;
                        if (seg == 1) {
                            float* o = samp ? out + O_KS + (idx - (size_t)8 * SEQ * 128) : out + O_KP + idx;
                            *(f32x4*)o = a; *(f32x4*)(o + 4) = b;
                        }
                    }
                    asm volatile("" ::: "memory");
                }
            return;
        }
#pragma unroll
        for (int ai = 0; ai < 2; ++ai)
#pragma unroll
            for (int m = 0; m < 4; ++m) {
                const int rl = rl0 + ai * 128 + m * 16, row = u.pm * 256 + rl;
                const float r = rsqrtf(ssq[row] * (1.0f / DM) + EPS);
                const int b_ = rl >> 4, t_ = rl & 15;
                if (seg == 2) {
                    bf16_t* vt = (bf16_t*)(ws + WS_VT);
#pragma unroll
                    for (int bj = 0; bj < 2; ++bj) {
                        const int head = sub * 2 + bj;
                        const f32x4 a = acc[ai][bj][m][0] * r, b = acc[ai][bj][m][1] * r;
                        if (!samp) {
                            float* o = out + O_VP + ((size_t)head * SEQ + row) * 128 + cw; *(f32x4*)o = a; *(f32x4*)(o + 4) = b;
                            bf16_t* v = vt + ((size_t)head * 128 + cw) * SEQ + row;
#pragma unroll
                            for (int j = 0; j < 4; ++j) { v[(size_t)j * SEQ] = to_bf16(a[j]); v[(size_t)(4 + j) * SEQ] = to_bf16(b[j]); }
                        } else {
                            float* o = out + O_VS + (((size_t)(b_ * 8 + head)) * 16 + t_) * 128 + cw; *(f32x4*)o = a; *(f32x4*)(o + 4) = b;
                            bf16_t* v = vt + (size_t)8 * 128 * SEQ + (((size_t)(b_ * 8 + head)) * 128 + cw) * 16 + t_;
#pragma unroll
                            for (int j = 0; j < 4; ++j) { v[j * 16] = to_bf16(a[j]); v[(4 + j) * 16] = to_bf16(b[j]); }
                        }
                    }
                } else if (seg == 3 || seg == 4) {
                    const int head = sub, pos = samp ? PAST + t_ : row;
                    const float* cs = rope + (size_t)pos * 128 + cw; const float* sn = cs + (size_t)SEQ * 128;
                    const f32x4 c0 = *(const f32x4*)cs, c1 = *(const f32x4*)(cs + 4), s0 = *(const f32x4*)sn, s1 = *(const f32x4*)(sn + 4);
                    const float sc = seg == 3 ? r : r * 0.0625f;
                    const f32x4 xa0 = acc[ai][0][m][0] * sc, xa1 = acc[ai][0][m][1] * sc, xb0 = acc[ai][1][m][0] * sc, xb1 = acc[ai][1][m][1] * sc;
                    const f32x4 lo0 = xa0 * c0 - xb0 * s0, lo1 = xa1 * c1 - xb1 * s1, hi0 = xa0 * s0 + xb0 * c0, hi1 = xa1 * s1 + xb1 * c1;
                    bf16_t* d = (bf16_t*)(ws + (seg == 3 ? WS_RQ : WS_RK));
                    const size_t idx = !samp ? ((size_t)head * SEQ + row) * 256 + cw : (size_t)4 * SEQ * 256 + (((size_t)(b_ * 4 + head)) * 16 + t_) * 256 + cw;
                    u32x4 w; w.x = pk_bf16(lo0[0], lo0[1]); w.y = pk_bf16(lo0[2], lo0[3]); w.z = pk_bf16(lo1[0], lo1[1]); w.w = pk_bf16(lo1[2], lo1[3]);
                    *(u32x4*)(d + idx) = w;
                    w.x = pk_bf16(hi0[0], hi0[1]); w.y = pk_bf16(hi0[2], hi0[3]); w.z = pk_bf16(hi1[0], hi1[1]); w.w = pk_bf16(hi1[2], hi1[3]);
                    *(u32x4*)(d + idx + 128) = w;
                    if (seg == 4) {
                        const float kd = exp2f(log2_gamma(head) * (float)(samp ? 15 - t_ : 63 - (row & 63)));
                        bf16_t* kt = (bf16_t*)(ws + WS_RKDT);
                        if (!samp) { bf16_t* v = kt + ((size_t)head * 256 + cw) * SEQ + row;
#pragma unroll
                            for (int j = 0; j < 4; ++j) { v[(size_t)j * SEQ] = to_bf16(lo0[j] * kd); v[(size_t)(4 + j) * SEQ] = to_bf16(lo1[j] * kd);
                                v[(size_t)(128 + j) * SEQ] = to_bf16(hi0[j] * kd); v[(size_t)(132 + j) * SEQ] = to_bf16(hi1[j] * kd); }
                        } else { bf16_t* v = kt + (size_t)4 * 256 * SEQ + (((size_t)(b_ * 4 + head)) * 256 + cw) * 16 + t_;
#pragma unroll
                            for (int j = 0; j < 4; ++j) { v[j * 16] = to_bf16(lo0[j] * kd); v[(4 + j) * 16] = to_bf16(lo1[j] * kd);
                                v[(128 + j) * 16] = to_bf16(hi0[j] * kd); v[(132 + j) * 16] = to_bf16(hi1[j] * kd); }
                        }
                    }
                } else if (seg == 5) {
                    const int head = sub; bf16_t* vt = (bf16_t*)(ws + WS_RVT);
#pragma unroll
                    for (int bj = 0; bj < 2; ++bj) {
                        const f32x4 a = acc[ai][bj][m][0] * r, b = acc[ai][bj][m][1] * r;
                        if (!samp) { bf16_t* v = vt + ((size_t)head * 256 + bj * 128 + cw) * SEQ + row;
#pragma unroll
                            for (int j = 0; j < 4; ++j) { v[(size_t)j * SEQ] = to_bf16(a[j]); v[(size_t)(4 + j) * SEQ] = to_bf16(b[j]); }
                        } else { bf16_t* v = vt + (size_t)4 * 256 * SEQ + (((size_t)(b_ * 4 + head)) * 256 + bj * 128 + cw) * 16 + t_;
#pragma unroll
                            for (int j = 0; j < 4; ++j) { v[j * 16] = to_bf16(a[j]); v[(4 + j) * 16] = to_bf16(b[j]); }
                        }
                    }
                } else {
                    bf16_t* g = (bf16_t*)(ws + WS_G);
#pragma unroll
                    for (int bj = 0; bj < 2; ++bj) {
                        const f32x4 a = acc[ai][bj][m][0] * r, b = acc[ai][bj][m][1] * r;
                        u32x4 w; w.x = pk_bf16(silu_f(a[0]), silu_f(a[1])); w.y = pk_bf16(silu_f(a[2]), silu_f(a[3])); w.z = pk_bf16(silu_f(b[0]), silu_f(b[1])); w.w = pk_bf16(silu_f(b[2]), silu_f(b[3]));
                        *(u32x4*)(g + (size_t)row * 1024 + sub * 256 + bj * 128 + cw) = w;
                    }
                }
                asm volatile("" ::: "memory");
            }
    }
};

#define MFMA32(a, b, c) __builtin_amdgcn_mfma_f32_32x32x16_bf16((a), (b), (c), 0, 0, 0)

struct TJob { const float* src; const float* gain; bf16_t* dst; int ld, lddst, k0, n0, mode; };
struct KP { const float* in[20]; float* out; unsigned char* ws; };
DI void tconv_load(const TJob& j, int tid, f32x4 (&v)[8]) {
    const int c4 = tid & 63, r = tid >> 6;
#pragma unroll
    for (int p = 0; p < 8; ++p) v[p] = *(const f32x4*)(j.src + (size_t)(j.k0 + r + 8 * p) * j.ld + j.n0 + c4 * 4);
}
DI void tconv_put(const TJob& j, int tid, const f32x4 (&v)[8], float* tile) {
    const int c4 = tid & 63, r = tid >> 6;
#pragma unroll
    for (int p = 0; p < 8; ++p) { f32x4 x = v[p]; if (j.gain) x *= j.gain[j.k0 + r + 8 * p]; *(f32x4*)(tile + (r + 8 * p) * 256 + ((c4 ^ p) << 2)) = x; }
}
DI void tconv_store(const TJob& j, int tid, const float* tile) {
#pragma unroll
    for (int q = 0; q < 4; ++q) {
        const int idx = tid + 512 * q, n = idx >> 3, kg = idx & 7;
        const float* t = tile + kg * 8 * 256 + (((n >> 2) ^ kg) << 2) + (n & 3);
        u32x4 w; w.x = pk_bf16(t[0], t[256]); w.y = pk_bf16(t[512], t[768]); w.z = pk_bf16(t[1024], t[1280]); w.w = pk_bf16(t[1536], t[1792]);
        const int nn = j.n0 + n, R = j.mode == 0 ? nn : 256 * (nn >> 7) + 128 * (j.mode - 1) + (nn & 127);
        *(u32x4*)(j.dst + (size_t)R * j.lddst + j.k0 + kg * 8) = w;
    }
}
constexpr int TC_GU = 32 * 22, TC_DN = 88 * 8, TC_IN = 32 * 28, TC_O = 32 * 8;
constexpr int TE1 = 2 * TC_GU, TE2 = TE1 + TC_DN, TE3 = TE2 + TC_IN, TE4 = TE3 + TC_O, TE6 = TE4 + 2 * TC_GU, TE7 = TE6 + TC_DN;
DI TJob tconv_job(const KP& p, int t) {
    TJob j; unsigned char* ws = p.ws;
    if (t < TE1 || (t >= TE4 && t < TE6)) {
        const bool second = t >= TE4; int tt = second ? t - TE4 : t; const int up = tt >= TC_GU; if (up) tt -= TC_GU;
        j.src = p.in[second ? (up ? 17 : 16) : (up ? 7 : 6)]; j.gain = p.in[second ? 15 : 5]; j.dst = (bf16_t*)(ws + (second ? WS_W2T : WS_W1T));
        j.ld = DFF; j.lddst = DM; j.k0 = (tt / 22) * 64; j.n0 = (tt % 22) * 256; j.mode = 1 + up;
    } else if (t < TE2 || t >= TE6) {
        const bool second = t >= TE6; const int tt = second ? t - TE6 : t - TE1;
        j.src = p.in[second ? 18 : 8]; j.gain = nullptr; j.dst = (bf16_t*)(ws + (second ? WS_WD2T : WS_WD1T)); j.ld = DM; j.lddst = DFF; j.k0 = (tt >> 3) * 64; j.n0 = (tt & 7) * 256; j.mode = 0;
    } else if (t < TE3) { const int tt = t - TE2;
        j.src = p.in[10]; j.gain = p.in[9]; j.dst = (bf16_t*)(ws + WS_WINT); j.ld = DIN; j.lddst = DM; j.k0 = (tt / 28) * 64; j.n0 = (tt % 28) * 256; j.mode = 0;
    } else { const int tt = t - TE3;
        j.src = p.in[14]; j.gain = nullptr; j.dst = (bf16_t*)(ws + WS_WOT); j.ld = DM; j.lddst = DM; j.k0 = (tt >> 3) * 64; j.n0 = (tt & 7) * 256; j.mode = 0;
    }
    return j;
}

DI void phase0(const KP& p, float* tile, int tid) {
    const int G = gridDim.x, bid = blockIdx.x;
    unsigned char* ws = p.ws;
    {
        f32x4 v[8]; TJob cur = tconv_job(p, bid < TE7 ? bid : 0);
        if (bid < TE7) tconv_load(cur, tid, v);
        for (int t = bid; t < TE7; t += G) {
            tconv_put(cur, tid, v, tile);
            TJob nxt = cur;
            if (t + G < TE7) { nxt = tconv_job(p, t + G); tconv_load(nxt, tid, v); }
            __syncthreads();
            tconv_store(cur, tid, tile);
            __syncthreads();
            cur = nxt;
        }
    }
    const int lane = tid & 63, wave = tid >> 6, gw = bid * 8 + wave, nw = G * 8;
    float* ssq = (float*)(ws + WS_SSQ); bf16_t* xn = (bf16_t*)(ws + WS_XN);
    for (int row = gw; row < MTOK; row += nw) {
        const float* x = row < SEQ ? p.in[0] + (size_t)row * DM : p.in[1] + (size_t)(row - SEQ) * DM;
        float sq = 0.f;
#pragma unroll
        for (int i = 0; i < 4; ++i) {
            const f32x4 a = *(const f32x4*)(x + i * 512 + lane * 8), b = *(const f32x4*)(x + i * 512 + lane * 8 + 4);
            sq += (a[0] * a[0] + a[1] * a[1]) + (a[2] * a[2] + a[3] * a[3]) + (b[0] * b[0] + b[1] * b[1]) + (b[2] * b[2] + b[3] * b[3]);
            u32x4 w; w.x = pk_bf16(a[0], a[1]); w.y = pk_bf16(a[2], a[3]); w.z = pk_bf16(b[0], b[1]); w.w = pk_bf16(b[2], b[3]);
            *(u32x4*)(xn + (size_t)row * DM + i * 512 + lane * 8) = w;
        }
#pragma unroll
        for (int o = 32; o >= 1; o >>= 1) sq += __shfl_xor(sq, o);
        if (lane == 0) { ssq[row] = sq; ssq[MTOK + row] = 0.f; ssq[2 * MTOK + row] = 0.f; ssq[3 * MTOK + row] = 0.f; }
    }
    float* rope = (float*)(ws + WS_ROPE);
    for (int e = bid * 512 + tid; e < SEQ * 128; e += G * 512) {
        const int pos = e >> 7, i = e & 127;
        const float inv = exp2f(-(float)i * (13.287712379549449f / 128.0f));
        const float ang = (float)pos * inv;
        const double rev = (double)ang * 0.15915494309189535; const float fr = (float)(rev - floor(rev));
        rope[e] = __builtin_amdgcn_cosf(fr); rope[(size_t)SEQ * 128 + e] = __builtin_amdgcn_sinf(fr);
    }
}

struct SbArgs {
    const bf16_t* q; int nq; int qpos0;
    const bf16_t* kA; const bf16_t* vtA; int ldv; int posA0, posA1;
    const float* kC; const float* vC;
    bf16_t* out;
};
DI void sb_unit(const SbArgs& a, int lane) {
    const int r = lane & 31, hl = lane >> 5;
    const int qr = r < a.nq ? r : a.nq - 1;
    bf16x8 qf[8];
#pragma unroll
    for (int ks = 0; ks < 8; ++ks) qf[ks] = *(const bf16x8*)(a.q + (size_t)qr * 128 + ks * 16 + hl * 8);
    const int qpos = a.qpos0 + qr;
    f32x16 o[4];
#pragma unroll
    for (int d = 0; d < 4; ++d)
#pragma unroll
        for (int i = 0; i < 16; ++i) o[d][i] = 0.f;
    float R = 0.f;
    for (int p0 = ((a.qpos0 + a.nq - 1) >> 5) << 5; p0 >= 0; p0 -= 32) {
        f32x16 st;
#pragma unroll
        for (int i = 0; i < 16; ++i) st[i] = 0.f;
        const bool fromA = p0 >= a.posA0;
        if (fromA) {
            int kr = p0 + r; kr = (kr < a.posA1 ? kr : a.posA1 - 1) - a.posA0;
            const bf16_t* kp = a.kA + (size_t)kr * 128 + hl * 8;
#pragma unroll
            for (int ks = 0; ks < 8; ++ks) st = MFMA32(*(const bf16x8*)(kp + ks * 16), qf[ks], st);
        } else {
            const float* kp = a.kC + (size_t)(p0 + r) * 128 + hl * 8;
#pragma unroll
            for (int ks = 0; ks < 8; ++ks) {
                const f32x4 x0 = *(const f32x4*)(kp + ks * 16), x1 = *(const f32x4*)(kp + ks * 16 + 4);
                u32x4 w; w.x = pk_bf16(x0[0], x0[1]); w.y = pk_bf16(x0[2], x0[3]); w.z = pk_bf16(x1[0], x1[1]); w.w = pk_bf16(x1[2], x1[3]);
                st = MFMA32(__builtin_bit_cast(bf16x8, w), qf[ks], st);
                if (ks & 1) asm volatile("" ::: "memory");
            }
        }
        float lk[16], gs[4], og[4], aft[4];
#pragma unroll
        for (int g = 0; g < 4; ++g) {
            gs[g] = 0.f;
#pragma unroll
            for (int e = 0; e < 4; ++e) {
                const int kpos = p0 + 8 * g + 4 * hl + e; const bool valid = kpos < qpos && kpos < a.posA1;
                const float l = valid ? -softplus_f(st[4 * g + e]) : 0.f; lk[4 * g + e] = l; gs[g] += l;
            }
            og[g] = __shfl_xor(gs[g], 32);
        }
        float tot = 0.f;
#pragma unroll
        for (int g = 3; g >= 0; --g) { aft[g] = tot; tot += gs[g] + og[g]; }
#pragma unroll
        for (int g = 0; g < 4; ++g) {
            float run = R + aft[g] + (hl == 0 ? og[g] : 0.f);
#pragma unroll
            for (int e = 3; e >= 0; --e) {
                const int kpos = p0 + 8 * g + 4 * hl + e; const bool valid = kpos < qpos && kpos < a.posA1;
                run += lk[4 * g + e];
                st[4 * g + e] = valid ? __expf(st[4 * g + e] + run) : 0.f;
            }
        }
        R += tot;
#pragma unroll
        for (int s2 = 0; s2 < 2; ++s2) {
            if (p0 + 16 * s2 < a.posA1) {
                u32x4 w; w.x = pk_bf16(st[8 * s2 + 0], st[8 * s2 + 1]); w.y = pk_bf16(st[8 * s2 + 2], st[8 * s2 + 3]); w.z = pk_bf16(st[8 * s2 + 4], st[8 * s2 + 5]); w.w = pk_bf16(st[8 * s2 + 6], st[8 * s2 + 7]);
                const bf16x8 pf = __builtin_bit_cast(bf16x8, w);
#pragma unroll
                for (int dt = 0; dt < 4; ++dt) {
                    const int d = dt * 32 + r; bf16x8 vf;
                    if (fromA) {
                        const bf16_t* vp = a.vtA + (size_t)d * a.ldv + (p0 - a.posA0) + 16 * s2 + 4 * hl;
                        const s16x4 lo = *(const s16x4*)vp, hi = *(const s16x4*)(vp + 8);
                        vf = __builtin_shufflevector(lo, hi, 0, 1, 2, 3, 4, 5, 6, 7);
                    } else {
                        const float* vp = a.vC + (size_t)(p0 + 16 * s2 + 4 * hl) * 128 + d;
                        u32x4 v; v.x = pk_bf16(vp[0], vp[128]); v.y = pk_bf16(vp[256], vp[384]); v.z = pk_bf16(vp[8 * 128], vp[9 * 128]); v.w = pk_bf16(vp[10 * 128], vp[11 * 128]);
                        vf = __builtin_bit_cast(bf16x8, v);
                    }
                    o[dt] = MFMA32(vf, pf, o[dt]);
                    asm volatile("" ::: "memory");
                }
            }
        }
        if (__ballot(R > -110.f) == 0ull) break;
    }
    if (r < a.nq) {
#pragma unroll
        for (int dt = 0; dt < 4; ++dt)
#pragma unroll
            for (int g = 0; g < 4; ++g) {
                u32x2 w; w.x = pk_bf16(o[dt][4 * g], o[dt][4 * g + 1]); w.y = pk_bf16(o[dt][4 * g + 2], o[dt][4 * g + 3]);
                *(u32x2*)(a.out + (size_t)r * DM + dt * 32 + 8 * g + 4 * hl) = w;
            }
    }
}

DI void reta_unit(const KP& p, int item, int w, int lane) {
    const int r = lane & 31, hl = lane >> 5;
    const bool samp = item >= 512;
    const bf16_t* kt = (const bf16_t*)(p.ws + WS_RKDT); const bf16_t* vt = (const bf16_t*)(p.ws + WS_RVT);
    if (!samp) {
        const int h = item >> 7, c = item & 127;
        const bf16_t* ka = kt + ((size_t)h * 256 + w * 32 + r) * SEQ + c * 64 + hl * 8;
        const bf16_t* vb = vt + ((size_t)h * 256 + r) * SEQ + c * 64 + hl * 8;
        bf16x8 A[4];
#pragma unroll
        for (int ks = 0; ks < 4; ++ks) A[ks] = *(const bf16x8*)(ka + ks * 16);
        bf16_t* o = (bf16_t*)(p.ws + WS_KVT) + (size_t)item * 65536;
#pragma unroll 1
        for (int d = 0; d < 8; ++d) {
            f32x16 acc;
#pragma unroll
            for (int i = 0; i < 16; ++i) acc[i] = 0.f;
#pragma unroll
            for (int ks = 0; ks < 4; ++ks) acc = MFMA32(A[ks], *(const bf16x8*)(vb + (size_t)d * 32 * SEQ + ks * 16), acc);
#pragma unroll
            for (int g = 0; g < 4; ++g) {
                u32x2 v; v.x = pk_bf16(acc[4 * g], acc[4 * g + 1]); v.y = pk_bf16(acc[4 * g + 2], acc[4 * g + 3]);
                *(u32x2*)(o + (size_t)(d * 32 + r) * 256 + w * 32 + 8 * g + 4 * hl) = v;
            }
        }
    } else {
        const int it = item - 512, h = it & 3;
        const bf16_t* ka = kt + (size_t)4 * 256 * SEQ + ((size_t)it * 256 + w * 32 + r) * 16 + hl * 8;
        const bf16_t* vb = vt + (size_t)4 * 256 * SEQ + ((size_t)it * 256 + r) * 16 + hl * 8;
        const bf16x8 A = *(const bf16x8*)ka;
        const float cdec = exp2f(log2_gamma(h) * 16.0f);
        const float* s0 = p.in[4] + (size_t)it * 65536; float* o = p.out + O_SS + (size_t)it * 65536;
#pragma unroll 1
        for (int d = 0; d < 8; ++d) {
            f32x16 acc;
#pragma unroll
            for (int i = 0; i < 16; ++i) acc[i] = 0.f;
            acc = MFMA32(A, *(const bf16x8*)(vb + (size_t)d * 32 * 16), acc);
#pragma unroll
            for (int i = 0; i < 16; ++i) {
                const size_t idx = (size_t)(w * 32 + (i & 3) + 8 * (i >> 2) + 4 * hl) * 256 + d * 32 + r;
                o[idx] = cdec * s0[idx] + acc[i];
            }
        }
    }
}

DI void scan_phase(const KP& p, int tid) {
    const bf16_t* kv = (const bf16_t*)(p.ws + WS_KVT); bf16_t* st = (bf16_t*)(p.ws + WS_ST);
    for (int e2 = blockIdx.x * 512 + tid; e2 < 4 * 32768; e2 += gridDim.x * 512) {
        const int h = e2 >> 15, e = (e2 & 32767) * 2;
        const float cdec = exp2f(log2_gamma(h) * 64.0f);
        float s0 = 0.f, s1 = 0.f;
        const size_t base = (size_t)h * 128 * 65536 + e;
#pragma unroll 32
        for (int c = 0; c < 128; ++c) {
            const unsigned kvv = *(const unsigned*)(kv + base + (size_t)c * 65536);
            *(unsigned*)(st + base + (size_t)c * 65536) = pk_bf16(s0, s1);
            s0 = cdec * s0 + __uint_as_float(kvv << 16); s1 = cdec * s1 + __uint_as_float(kvv & 0xffff0000u);
        }
        const int dv = e >> 8, dk = e & 255;
        float* o = p.out + O_SP + (size_t)h * 65536;
        o[(size_t)dk * 256 + dv] = s0; o[(size_t)(dk + 1) * 256 + dv] = s1;
    }
}

struct RcArgs {
    const bf16_t* q; int nq; int i0;
    const bf16_t* k; int nk;
    const bf16_t* vt; int ldv;
    const bf16_t* st;
    float l2g;
    const float* gain;
    const bf16_t* gate;
    bf16_t* out;
};
DI void retc_unit(const RcArgs& a, int lane) {
    const int r = lane & 31, hl = lane >> 5;
    const int qr = r < a.nq ? r : a.nq - 1, qi = a.i0 + qr;
    const bf16_t* qp = a.q + (size_t)qr * 256 + hl * 8;
    f32x16 acc[8];
#pragma unroll
    for (int d = 0; d < 8; ++d)
#pragma unroll
        for (int i = 0; i < 16; ++i) acc[d][i] = 0.f;
#pragma unroll 2
    for (int ks = 0; ks < 16; ++ks) {
        const bf16x8 B = *(const bf16x8*)(qp + ks * 16);
#pragma unroll
        for (int d = 0; d < 8; ++d) acc[d] = MFMA32(*(const bf16x8*)(a.st + (size_t)(d * 32 + r) * 256 + ks * 16 + hl * 8), B, acc[d]);
    }
    const float qdec = exp2f(a.l2g * (float)(qi + 1));
#pragma unroll
    for (int d = 0; d < 8; ++d)
#pragma unroll
        for (int i = 0; i < 16; ++i) acc[d][i] *= qdec;
    const int nblk = (a.i0 + a.nq + 31) >> 5;
    for (int jb = 0; jb < nblk; ++jb) {
        f32x16 st;
#pragma unroll
        for (int i = 0; i < 16; ++i) st[i] = 0.f;
        int kr = jb * 32 + r; kr = kr < a.nk ? kr : a.nk - 1;
        const bf16_t* kp = a.k + (size_t)kr * 256 + hl * 8;
#pragma unroll 4
        for (int ks = 0; ks < 16; ++ks) st = MFMA32(*(const bf16x8*)(kp + ks * 16), *(const bf16x8*)(qp + ks * 16), st);
#pragma unroll
        for (int i = 0; i < 16; ++i) {
            const int j = jb * 32 + (i & 3) + 8 * (i >> 2) + 4 * hl;
            st[i] = (j <= qi && j < a.nk) ? st[i] * exp2f(a.l2g * (float)(qi - j)) : 0.f;
        }
#pragma unroll
        for (int s2 = 0; s2 < 2; ++s2) {
            if (jb * 32 + 16 * s2 < a.nk) {
                u32x4 w; w.x = pk_bf16(st[8 * s2 + 0], st[8 * s2 + 1]); w.y = pk_bf16(st[8 * s2 + 2], st[8 * s2 + 3]); w.z = pk_bf16(st[8 * s2 + 4], st[8 * s2 + 5]); w.w = pk_bf16(st[8 * s2 + 6], st[8 * s2 + 7]);
                const bf16x8 pf = __builtin_bit_cast(bf16x8, w);
#pragma unroll
                for (int d = 0; d < 8; ++d) {
                    const bf16_t* vp = a.vt + (size_t)(d * 32 + r) * a.ldv + jb * 32 + 16 * s2 + 4 * hl;
                    const s16x4 lo = *(const s16x4*)vp, hi = *(const s16x4*)(vp + 8);
                    acc[d] = MFMA32(__builtin_shufflevector(lo, hi, 0, 1, 2, 3, 4, 5, 6, 7), pf, acc[d]);
                }
            }
        }
    }
    float ss = 0.f;
#pragma unroll
    for (int d = 0; d < 8; ++d)
#pragma unroll
        for (int i = 0; i < 16; ++i) ss += acc[d][i] * acc[d][i];
    ss += __shfl_xor(ss, 32);
    const float rs = rsqrtf(ss * (1.0f / 256.0f) + EPS);
    if (r < a.nq) {
#pragma unroll
        for (int d = 0; d < 8; ++d)
#pragma unroll
            for (int g = 0; g < 4; ++g) {
                const int dv = d * 32 + 8 * g + 4 * hl;
                const f32x4 gn = *(const f32x4*)(a.gain + dv);
                const u32x2 gt = *(const u32x2*)(a.gate + (size_t)r * 1024 + dv);
                const float g0 = __uint_as_float(gt.x << 16), g1 = __uint_as_float(gt.x & 0xffff0000u), g2 = __uint_as_float(gt.y << 16), g3 = __uint_as_float(gt.y & 0xffff0000u);
                u32x2 w; w.x = pk_bf16(acc[d][4 * g] * rs * gn[0] * g0, acc[d][4 * g + 1] * rs * gn[1] * g1); w.y = pk_bf16(acc[d][4 * g + 2] * rs * gn[2] * g2, acc[d][4 * g + 3] * rs * gn[3] * g3);
                *(u32x2*)(a.out + (size_t)r * DM + dv) = w;
            }
    }
}

DI void skinny_resid(const bf16_t* __restrict__ A, const bf16_t* __restrict__ Bt, int K, const float* xin, float* xo, bf16_t* xb, float* ssq, float scale, float* red, int tid) {
    const int lane = tid & 63, wave = __builtin_amdgcn_readfirstlane(tid >> 6), r = lane & 31, hl = lane >> 5, ks = wave & 3, Kq = K >> 2;
    for (int pr = blockIdx.x; pr < 256; pr += gridDim.x) {
        const int T = pr * 2 + (wave >> 2), rt = T >> 6, ct = T & 63;
        const bf16_t* ap = Bt + (size_t)(ct * 32 + r) * K + ks * Kq + hl * 8;
        const bf16_t* bp = A + (size_t)(rt * 32 + r) * K + ks * Kq + hl * 8;
        f32x16 acc;
#pragma unroll
        for (int i = 0; i < 16; ++i) acc[i] = 0.f;
#pragma unroll 8
        for (int k = 0; k < Kq; k += 16) acc = MFMA32(*(const bf16x8*)(ap + k), *(const bf16x8*)(bp + k), acc);
#pragma unroll
        for (int i = 0; i < 16; ++i) red[(wave * 16 + i) * 64 + lane] = acc[i];
        __syncthreads();
        if (ks == 0) {
#pragma unroll
            for (int i = 0; i < 16; ++i) acc[i] += (red[((wave + 1) * 16 + i) * 64 + lane] + red[((wave + 2) * 16 + i) * 64 + lane]) + red[((wave + 3) * 16 + i) * 64 + lane];
            const int token = rt * 32 + r; float sq = 0.f;
#pragma unroll
            for (int g = 0; g < 4; ++g) {
                const size_t off = (size_t)token * DM + ct * 32 + 8 * g + 4 * hl;
                const f32x4 x = *(const f32x4*)(xin + off);
                f32x4 y; y[0] = x[0] + scale * acc[4 * g]; y[1] = x[1] + scale * acc[4 * g + 1]; y[2] = x[2] + scale * acc[4 * g + 2]; y[3] = x[3] + scale * acc[4 * g + 3];
                *(f32x4*)(xo + off) = y;
                u32x2 w; w.x = pk_bf16(y[0], y[1]); w.y = pk_bf16(y[2], y[3]); *(u32x2*)(xb + off) = w;
                sq += (y[0] * y[0] + y[1] * y[1]) + (y[2] * y[2] + y[3] * y[3]);
            }
            sq += __shfl_xor(sq, 32);
            if (hl == 0) atomicAdd(ssq + token, sq);
        }
        __syncthreads();
    }
}

constexpr int LDS_BYTES = pg8::STAGE_BYTES + 8192;
__global__ void __launch_bounds__(512, 2) fwd_kernel(KP p) {
    extern __shared__ __attribute__((aligned(16))) unsigned char lds[];
    cg::grid_group grid = cg::this_grid();
#define FRESH_IDS() int tid = threadIdx.x; asm volatile("" : "+v"(tid)); const int lane = tid & 63, wave = __builtin_amdgcn_readfirstlane(tid >> 6); (void)lane; (void)wave
    const int G = gridDim.x, bid = blockIdx.x;
    unsigned char* ws = p.ws;
    PG8_LAS unsigned char* l3 = (PG8_LAS unsigned char*)lds;
    float* ssq = (float*)(ws + WS_SSQ);
    bf16_t* XN = (bf16_t*)(ws + WS_XN); bf16_t* H = (bf16_t*)(ws + WS_H); float* X1 = (float*)(ws + WS_X1); bf16_t* MIX = (bf16_t*)(ws + WS_MIX);

    { FRESH_IDS(); phase0(p, (float*)lds, tid); }
    grid.sync();
    {
        pg8::Gemm g{XN, (const bf16_t*)(ws + WS_W1T), MTOK, 2 * DFF, DM}; pg8::StaticOrder S; S.init(MTOK, 2 * DFF, G, bid);
        EpiSwiglu E{H, ssq};
        pg8::gemm_phase<EpiSwiglu, pg8::StaticOrder>(l3, g, S, E, nullptr);
    }
    grid.sync();
    {
        pg8::Gemm g{H, (const bf16_t*)(ws + WS_WD1T), SEQ, DM, DFF}; pg8::StaticOrder S; S.init(SEQ, DM, G, bid);
        EpiResid E{p.in[0], p.in[1], X1, XN, ssq + MTOK, 0.5f};
        pg8::gemm_phase<EpiResid, pg8::StaticOrder>(l3, g, S, E, nullptr);
        { FRESH_IDS(); skinny_resid(H + (size_t)SEQ * DFF, (const bf16_t*)(ws + WS_WD1T), DFF, p.in[1], X1 + (size_t)SEQ * DM, XN + (size_t)SEQ * DM, ssq + MTOK + SEQ, 0.5f, (float*)lds, tid); }
    }
    grid.sync();
    {
        pg8::Gemm g{XN, (const bf16_t*)(ws + WS_WINT), MTOK, DIN, DM}; pg8::StaticOrder S; S.init(MTOK, DIN, G, bid);
        EpiIn E{ssq + MTOK, p.in[11], p.in[12], (const float*)(ws + WS_ROPE), p.out, ws, (float*)(lds + pg8::STAGE_BYTES)};
        pg8::gemm_phase<EpiIn, pg8::StaticOrder>(l3, g, S, E, nullptr);
    }
    grid.sync();
    {
        FRESH_IDS();
        for (int tt = bid; tt < 256; tt += G) {
            TJob j; j.src = p.in[4] + (size_t)(tt >> 2) * 65536; j.gain = nullptr; j.dst = (bf16_t*)(ws + WS_ST) + (size_t)(512 + (tt >> 2)) * 65536; j.ld = 256; j.lddst = 256; j.k0 = (tt & 3) * 64; j.n0 = 0; j.mode = 0;
            f32x4 v[8]; tconv_load(j, tid, v); tconv_put(j, tid, v, (float*)lds); __syncthreads(); tconv_store(j, tid, (float*)lds); __syncthreads();
        }
        const int gw = bid * 8 + wave, nw = G * 8;
        constexpr int U_RA = 576 * 8, U_SBP = 8 * 256, U_SBS = 128;
        for (int u = gw; u < U_RA + U_SBP + U_SBS; u += nw) {
            if (u < U_RA) reta_unit(p, u >> 3, u & 7, lane);
            else if (u < U_RA + U_SBP) {
                const int v = u - U_RA, h = v >> 8, qb = 255 - (v & 255);
                SbArgs a; a.q = (const bf16_t*)(ws + WS_QB) + ((size_t)h * SEQ + qb * 32) * 128; a.nq = 32; a.qpos0 = qb * 32;
                a.kA = (const bf16_t*)(ws + WS_KB) + (size_t)h * SEQ * 128; a.vtA = (const bf16_t*)(ws + WS_VT) + (size_t)h * 128 * SEQ; a.ldv = SEQ; a.posA0 = 0; a.posA1 = SEQ;
                a.kC = nullptr; a.vC = nullptr; a.out = MIX + (size_t)(qb * 32) * DM + h * 128;
                sb_unit(a, lane);
            } else {
                const int bh = u - U_RA - U_SBP, b = bh >> 3, h = bh & 7;
                SbArgs a; a.q = (const bf16_t*)(ws + WS_QB) + (size_t)8 * SEQ * 128 + (size_t)bh * 16 * 128; a.nq = 16; a.qpos0 = PAST;
                a.kA = (const bf16_t*)(ws + WS_KB) + (size_t)8 * SEQ * 128 + (size_t)bh * 16 * 128; a.vtA = (const bf16_t*)(ws + WS_VT) + (size_t)8 * 128 * SEQ + (size_t)bh * 128 * 16; a.ldv = 16; a.posA0 = PAST; a.posA1 = PAST + DECS;
                a.kC = p.in[2] + (size_t)bh * PAST * 128; a.vC = p.in[3] + (size_t)bh * PAST * 128; a.out = MIX + (size_t)(SEQ + b * 16) * DM + h * 128;
                sb_unit(a, lane);
            }
        }
    }
    grid.sync();
    { FRESH_IDS(); scan_phase(p, tid); }
    grid.sync();
    {
        FRESH_IDS();
        const int gw = bid * 8 + wave, nw = G * 8;
        for (int u = gw; u < 1024 + 64; u += nw) {
            RcArgs a;
            if (u < 1024) {
                const int item = u >> 1, half = u & 1, h = item >> 7, c = item & 127, tok = c * 64 + half * 32;
                a.q = (const bf16_t*)(ws + WS_RQ) + ((size_t)h * SEQ + tok) * 256; a.nq = 32; a.i0 = half * 32;
                a.k = (const bf16_t*)(ws + WS_RK) + ((size_t)h * SEQ + c * 64) * 256; a.nk = 64;
                a.vt = (const bf16_t*)(ws + WS_RVT) + (size_t)h * 256 * SEQ + c * 64; a.ldv = SEQ;
                a.st = (const bf16_t*)(ws + WS_ST) + (size_t)item * 65536; a.l2g = log2_gamma(h); a.gain = p.in[13] + h * 256;
                a.gate = (const bf16_t*)(ws + WS_G) + (size_t)tok * 1024 + h * 256; a.out = MIX + (size_t)tok * DM + 1024 + h * 256;
            } else {
                const int it = u - 1024, b = it >> 2, h = it & 3, row = SEQ + b * 16;
                a.q = (const bf16_t*)(ws + WS_RQ) + (size_t)4 * SEQ * 256 + (size_t)it * 16 * 256; a.nq = 16; a.i0 = 0;
                a.k = (const bf16_t*)(ws + WS_RK) + (size_t)4 * SEQ * 256 + (size_t)it * 16 * 256; a.nk = 16;
                a.vt = (const bf16_t*)(ws + WS_RVT) + (size_t)4 * 256 * SEQ + (size_t)it * 256 * 16; a.ldv = 16;
                a.st = (const bf16_t*)(ws + WS_ST) + (size_t)(512 + it) * 65536; a.l2g = log2_gamma(h); a.gain = p.in[13] + h * 256;
                a.gate = (const bf16_t*)(ws + WS_G) + (size_t)row * 1024 + h * 256; a.out = MIX + (size_t)row * DM + 1024 + h * 256;
            }
            retc_unit(a, lane);
        }
    }
    grid.sync();
    {
        pg8::Gemm g{MIX, (const bf16_t*)(ws + WS_WOT), SEQ, DM, DM}; pg8::StaticOrder S; S.init(SEQ, DM, G, bid);
        EpiResid E{X1, X1 + (size_t)SEQ * DM, X1, XN, ssq + 2 * MTOK, 1.0f};
        pg8::gemm_phase<EpiResid, pg8::StaticOrder>(l3, g, S, E, nullptr);
        { FRESH_IDS(); skinny_resid(MIX + (size_t)SEQ * DM, (const bf16_t*)(ws + WS_WOT), DM, X1 + (size_t)SEQ * DM, X1 + (size_t)SEQ * DM, XN + (size_t)SEQ * DM, ssq + 2 * MTOK + SEQ, 1.0f, (float*)lds, tid); }
    }
    grid.sync();
    {
        pg8::Gemm g{XN, (const bf16_t*)(ws + WS_W2T), MTOK, 2 * DFF, DM}; pg8::StaticOrder S; S.init(MTOK, 2 * DFF, G, bid);
        EpiSwiglu E{H, ssq + 2 * MTOK};
        pg8::gemm_phase<EpiSwiglu, pg8::StaticOrder>(l3, g, S, E, nullptr);
    }
    grid.sync();
    {
        pg8::Gemm g{H, (const bf16_t*)(ws + WS_WD2T), SEQ, DM, DFF}; pg8::StaticOrder S; S.init(SEQ, DM, G, bid);
        EpiResid E{X1, X1 + (size_t)SEQ * DM, X1, XN, ssq + 3 * MTOK, 0.5f};
        pg8::gemm_phase<EpiResid, pg8::StaticOrder>(l3, g, S, E, nullptr);
        { FRESH_IDS(); skinny_resid(H + (size_t)SEQ * DFF, (const bf16_t*)(ws + WS_WD2T), DFF, X1 + (size_t)SEQ * DM, X1 + (size_t)SEQ * DM, XN + (size_t)SEQ * DM, ssq + 3 * MTOK + SEQ, 0.5f, (float*)lds, tid); }
    }
    grid.sync();
    {
        FRESH_IDS();
        const int gw = bid * 8 + wave, nw = G * 8; const float* fn = p.in[19];
        for (int row = gw; row < MTOK; row += nw) {
            const float rs = rsqrtf(ssq[3 * MTOK + row] * (1.0f / DM) + EPS);
            const float* x = X1 + (size_t)row * DM; float* y = p.out + O_Y + (size_t)row * DM;
#pragma unroll
            for (int i = 0; i < 8; ++i) { const int c = i * 256 + lane * 4; *(f32x4*)(y + c) = *(const f32x4*)(x + c) * rs * *(const f32x4*)(fn + c); }
        }
    }
}

extern "C" void kernel_launch(void* const* d_in, const int* in_sizes, int n_in, void* d_out, int out_size, void* d_ws, size_t ws_size, hipStream_t stream) {
    static int grid_blocks = 0;
    if (!grid_blocks) {
        if (n_in != 20 || ws_size < WS_END) { fprintf(stderr, "kernel_launch: need 20 inputs and %zu bytes of workspace (got %d, %zu)\n", (size_t)WS_END, n_in, ws_size); grid_blocks = -1; return; }
        int dev = 0, cus = 0, per_cu = 0;
        hipGetDevice(&dev);
        hipDeviceGetAttribute(&cus, hipDeviceAttributeMultiprocessorCount, dev);
        hipFuncSetAttribute((const void*)fwd_kernel, hipFuncAttributeMaxDynamicSharedMemorySize, LDS_BYTES);
        hipOccupancyMaxActiveBlocksPerMultiprocessor(&per_cu, (const void*)fwd_kernel, 512, LDS_BYTES);
        if (per_cu < 1) { fprintf(stderr, "kernel_launch: occupancy query says %d blocks per CU\n", per_cu); per_cu = 1; }
        grid_blocks = cus;
    }
    if (grid_blocks < 0) return;
    KP p{};
    for (int i = 0; i < 20; ++i) p.in[i] = (const float*)d_in[i];
    p.out = (float*)d_out; p.ws = (unsigned char*)d_ws;
    void* args[] = {&p};
    hipError_t e = hipLaunchCooperativeKernel((const void*)fwd_kernel, dim3(grid_blocks), dim3(512), args, LDS_BYTES, stream);
    if (e != hipSuccess) fprintf(stderr, "cooperative launch failed: %s (grid %d)\n", hipGetErrorString(e), grid_blocks);
}
```

```cpp
#include <hip/hip_runtime.h>
#include <hip/hip_cooperative_groups.h>
#include <cstdio>
namespace cg = cooperative_groups;

#define DI __device__ __forceinline__
typedef unsigned short bf16_t;
typedef short bf16x8 __attribute__((ext_vector_type(8)));
typedef short s16x4 __attribute__((ext_vector_type(4)));
typedef float f32x4 __attribute__((ext_vector_type(4)));
typedef float f32x2 __attribute__((ext_vector_type(2)));
typedef float f32x16 __attribute__((ext_vector_type(16)));
typedef unsigned u32x4 __attribute__((ext_vector_type(4)));
typedef unsigned u32x2 __attribute__((ext_vector_type(2)));

constexpr int DM = 2048, SEQ = 8192, NSAMP = 256, MTOK = SEQ + NSAMP, DFF = 5632, DIN = 7168, PAST = 2048, DECS = 16, DECB = 16;
constexpr float EPS = 1e-6f;

constexpr size_t al256(size_t x) { return (x + 255) & ~(size_t)255; }
constexpr size_t WS_W1T = 0;
constexpr size_t WS_WD1T = WS_W1T + (size_t)2 * DFF * DM * 2;
constexpr size_t WS_WINT = WS_WD1T + (size_t)DM * DFF * 2;
constexpr size_t WS_WOT = WS_WINT + (size_t)DIN * DM * 2;
constexpr size_t WS_W2T = WS_WOT + (size_t)DM * DM * 2;
constexpr size_t WS_WD2T = WS_W2T + (size_t)2 * DFF * DM * 2;
constexpr size_t WS_XN = WS_WD2T + (size_t)DM * DFF * 2;
constexpr size_t WS_H = WS_XN + (size_t)MTOK * DM * 2;
constexpr size_t WS_ST = WS_H;
constexpr size_t WS_X1 = WS_H + (size_t)MTOK * DFF * 2;
constexpr size_t WS_SSQ = WS_X1 + (size_t)MTOK * DM * 4;
constexpr size_t WS_QB = al256(WS_SSQ + (size_t)4 * MTOK * 4);
constexpr size_t SEG_B = (size_t)MTOK * 1024 * 2;
constexpr size_t WS_KB = WS_QB + SEG_B;
constexpr size_t WS_VT = WS_KB + SEG_B;
constexpr size_t WS_RQ = WS_VT + SEG_B;
constexpr size_t WS_RK = WS_RQ + SEG_B;
constexpr size_t WS_RKDT = WS_RK + SEG_B;
constexpr size_t WS_RVT = WS_RKDT + SEG_B;
constexpr size_t WS_G = WS_RVT + SEG_B;
constexpr size_t WS_MIX = WS_G + SEG_B;
constexpr size_t WS_KVT = WS_MIX + (size_t)MTOK * DM * 2;
constexpr size_t WS_ROPE = WS_KVT + (size_t)512 * 65536 * 2;
constexpr size_t WS_BAR = WS_ROPE + (size_t)2 * SEQ * 128 * 4;
constexpr size_t WS_END = WS_BAR + 16384;
static_assert((size_t)576 * 65536 * 2 <= (size_t)MTOK * DFF * 2, "ST must fit in H");

constexpr size_t O_Y = 0;
constexpr size_t O_KP = (size_t)MTOK * DM;
constexpr size_t O_VP = O_KP + (size_t)8 * SEQ * 128;
constexpr size_t O_SP = O_VP + (size_t)8 * SEQ * 128;
constexpr size_t O_KS = O_SP + (size_t)4 * 65536;
constexpr size_t O_VS = O_KS + (size_t)DECB * 8 * DECS * 128;
constexpr size_t O_SS = O_VS + (size_t)DECB * 8 * DECS * 128;

DI unsigned pk_bf16(float a, float b) {
    typedef __bf16 bf2 __attribute__((ext_vector_type(2)));
    bf2 v; v[0] = (__bf16)a; v[1] = (__bf16)b; return __builtin_bit_cast(unsigned, v);
}
DI bf16_t to_bf16(float a) { return __builtin_bit_cast(bf16_t, (__bf16)a); }
DI float silu_f(float g) { return g * __builtin_amdgcn_rcpf(1.f + __expf(-g)); }
DI float softplus_f(float z) { return fmaxf(z, 0.f) + __logf(1.f + __expf(-fabsf(z))); }
DI float log2_gamma(int h) { return __log2f(1.0f - exp2f(-5.0f - (float)h)); }

namespace pg8 {
#define PG8_LAS __attribute__((address_space(3)))
typedef unsigned short bf16_t;
typedef short bf16x8 __attribute__((ext_vector_type(8)));
typedef float f32x4 __attribute__((ext_vector_type(4)));
typedef unsigned u32x4 __attribute__((ext_vector_type(4)));
constexpr int BM = 256, BK = 64, HALF = 128, HTB = HALF * BK * 2  , STAGE_BYTES = 8 * HTB, NXCD = 8, WGM = 8;

__host__ __device__ __forceinline__ int lds_byte(int r, int c) { const int st = (r >> 4) * 2 + (c >> 5), rr = r & 15, cc = c & 31, ob = rr * 64 + cc * 2; return st * 1024 + (ob ^ (((ob >> 9) & 1) << 5)); }
__host__ __device__ __forceinline__ void stage_rc(int b, int& R, int& C) { const int st = b / 1024, sb = b % 1024, swz = sb ^ (((sb >> 9) & 1) << 5); R = (st >> 1) * 16 + swz / 64; C = (st & 1) * 32 + (swz % 64) / 2; }
__host__ __device__ __forceinline__ int perm32(int rho) { const int n = rho >> 4, i = rho & 15; return 8 * (i >> 2) + 4 * n + (i & 3); }

struct Unit { int pm, pn; };
struct Gemm { const bf16_t* A; const bf16_t* Bt; int M, N, K; };

struct StaticOrder {
    int nM, nN, nwg, G, c;
    __host__ __device__ void init(int M, int N, int G_, int c_) { nM = M / BM; nN = N / BM; nwg = nM * nN; G = G_; c = c_; }
    __host__ __device__ bool next(int i, Unit& u) const {
        const long L = (long)i * G + c; if (L >= nwg) return false;
        int wgid = (int)L; { const int q = nwg / NXCD, r = nwg % NXCD, xcd = wgid % NXCD, off = wgid / NXCD; wgid = (xcd < r ? xcd * (q + 1) : r * (q + 1) + (xcd - r) * q) + off; }
        const int nig = WGM * nN, gid = wgid / nig, fm = gid * WGM, gsz = (nM - fm) < WGM ? (nM - fm) : WGM;
        u.pm = fm + ((wgid % nig) % gsz); u.pn = (wgid % nig) / gsz; return true;
    }
    __device__ __forceinline__ void a_ready(const Unit&) const {}
    __device__ __forceinline__ void done(const Unit&) const {}
};
template <class Epi, class Sched, bool STAMP = false>
__device__ __forceinline__ void gemm_phase(PG8_LAS unsigned char* lds, const Gemm g, const Sched& S, const Epi& E, unsigned long long* stamps) {
    int tid_ = threadIdx.x; asm volatile("" : "+v"(tid_));
    const int tid = tid_, wid = __builtin_amdgcn_readfirstlane(tid >> 6), lane = tid & 63, wr = wid >> 2, wc = wid & 3, fr = lane & 15, fq = lane >> 4;
    const int K = g.K, nt = K / BK;
    int ts_lo = 0, ts_hi = 0, nts = 0; const unsigned long long rt_entry = STAMP ? (unsigned long long)wall_clock64() : 0ull;
#define PG8_STAMP() do { if (STAMP && wid == 0 && nts < 64) { const unsigned long long _c = (unsigned long long)clock64(); \
        ts_lo = (lane == nts) ? (int)(unsigned)_c : ts_lo; ts_hi = (lane == nts) ? (int)(unsigned)(_c >> 32) : ts_hi; ++nts; } } while (0)
    PG8_STAMP();
    unsigned voffA[2], voffB[2];
#pragma unroll
    for (int i = 0; i < 2; ++i) { int R, C; stage_rc(tid * 16 + i * 8192, R, C); const int Rb = Epi::PERM ? ((R & ~31) + perm32(R & 31)) : R;
        voffA[i] = (unsigned)(R * K + C) * 2u; voffB[i] = (unsigned)(Rb * K + C) * 2u; }
    const size_t kstep = (size_t)(BK * 2);
    const size_t hstep = (size_t)HALF * K * 2;
    const size_t tstep = 2 * hstep;
    const unsigned ldsw = (unsigned)wid * 1024u;
    const int aoff = lds_byte(wr * 64 + fr, fq * 8), boff = lds_byte(wc * 32 + fr, fq * 8);
#define PG8_SA(b, h) (((b) * 2 + (h)) * HTB)
#define PG8_SB(b, h) ((4 + (b) * 2 + (h)) * HTB)
#define PG8_STAGE(bufoff, gbase, voff) do { _Pragma("unroll") for (int _i = 0; _i < 2; ++_i) \
        __builtin_amdgcn_global_load_lds((const unsigned*)((const char*)(gbase) + (voff)[_i]), (PG8_LAS unsigned*)(lds + (bufoff) + ldsw + _i * 8192), 16, 0, 0); } while (0)
#define PG8_LDA(dst, b, h) do { _Pragma("unroll") for (int m = 0; m < 4; ++m) _Pragma("unroll") for (int k = 0; k < 2; ++k) dst[m][k] = *(const PG8_LAS bf16x8*)(lds + PG8_SA(b, h) + aoff + m * 2048 + k * 1024); } while (0)
#define PG8_LDB(dst, b, h) do { _Pragma("unroll") for (int n = 0; n < 2; ++n) _Pragma("unroll") for (int k = 0; k < 2; ++k) dst[n][k] = *(const PG8_LAS bf16x8*)(lds + PG8_SB(b, h) + boff + n * 2048 + k * 1024); } while (0)
#define PG8_MMA(ai, bj, At, Bt) do { __builtin_amdgcn_s_setprio(1); _Pragma("unroll") for (int m = 0; m < 4; ++m) _Pragma("unroll") for (int n = 0; n < 2; ++n) _Pragma("unroll") for (int k = 0; k < 2; ++k) \
        acc[ai][bj][m][n] = __builtin_amdgcn_mfma_f32_16x16x32_bf16(Bt[n][k], At[m][k], acc[ai][bj][m][n], 0, 0, 0); __builtin_amdgcn_s_setprio(0); } while (0)
#define PG8_WAIT_V(n) asm volatile("s_waitcnt vmcnt(" #n ")" ::: "memory")
#define PG8_WAIT_L(n) asm volatile("s_waitcnt lgkmcnt(" #n ")" ::: "memory")
#define PG8_BAR __builtin_amdgcn_s_barrier()
#define PG8_SCHED __builtin_amdgcn_sched_barrier(0)
    Unit cur, nxt; int ui = 0;
    if (!S.next(0, cur)) return;
    f32x4 acc[2][2][4][2];
#pragma unroll
    for (int a = 0; a < 2; ++a)
#pragma unroll
        for (int b = 0; b < 2; ++b)
#pragma unroll
            for (int m = 0; m < 4; ++m)
#pragma unroll
                for (int n = 0; n < 2; ++n) acc[a][b][m][n] = (f32x4){0.f, 0.f, 0.f, 0.f};
    bf16x8 At[4][2], B0[2][2], B1[2][2];
    const char* cA = (const char*)g.A + (size_t)cur.pm * tstep; const char* cB = (const char*)g.Bt + (size_t)cur.pn * tstep;
    S.a_ready(cur);
    PG8_STAGE(PG8_SB(0, 0), cB, voffB); PG8_STAGE(PG8_SA(0, 0), cA, voffA); PG8_STAGE(PG8_SB(0, 1), cB + hstep, voffB); PG8_STAGE(PG8_SA(0, 1), cA + hstep, voffA);
    if (wr == 1) PG8_BAR;
    PG8_WAIT_V(4); PG8_BAR;
    PG8_STAGE(PG8_SB(1, 0), cB + kstep, voffB); PG8_STAGE(PG8_SA(1, 0), cA + kstep, voffA); PG8_STAGE(PG8_SB(1, 1), cB + hstep + kstep, voffB);
    PG8_WAIT_V(6); PG8_BAR;
    PG8_STAMP();
    for (;;) {
        const bool has_next = S.next(ui + 1, nxt);
        const char* nA = has_next ? (const char*)g.A + (size_t)nxt.pm * tstep : cA; const char* nB = has_next ? (const char*)g.Bt + (size_t)nxt.pn * tstep : cB;
        for (int t = 0; t < nt; t += 2) {
            const bool last = (t == nt - 2);
            const char* a1 = cA + (size_t)(t + 1) * kstep;
            const char* a2 = last ? nA : cA + (size_t)(t + 2) * kstep; const char* b2 = last ? nB : cB + (size_t)(t + 2) * kstep;
            const char* a3 = a2 + kstep; const char* b3 = b2 + kstep;
            if (last && has_next) S.a_ready(nxt);
            PG8_LDB(B0, 0, 0); PG8_SCHED; PG8_LDA(At, 0, 0); PG8_STAGE(PG8_SA(1, 1), a1 + hstep, voffA);
            PG8_WAIT_L(8); PG8_BAR; PG8_WAIT_L(0); PG8_MMA(0, 0, At, B0); PG8_BAR; PG8_SCHED;
            PG8_LDB(B1, 0, 1); PG8_STAGE(PG8_SB(0, 0), b2, voffB);
            PG8_BAR; PG8_WAIT_L(0); PG8_MMA(0, 1, At, B1); PG8_BAR;
            PG8_LDA(At, 0, 1); PG8_STAGE(PG8_SA(0, 0), a2, voffA);
            PG8_BAR; PG8_WAIT_L(0); PG8_MMA(1, 0, At, B0); PG8_BAR; PG8_SCHED;
            PG8_STAGE(PG8_SB(0, 1), b2 + hstep, voffB);
            PG8_WAIT_V(6); PG8_BAR; PG8_MMA(1, 1, At, B1); PG8_BAR;
            PG8_LDB(B0, 1, 0); PG8_SCHED; PG8_LDA(At, 1, 0); PG8_STAGE(PG8_SA(0, 1), a2 + hstep, voffA);
            PG8_WAIT_L(8); PG8_BAR; PG8_WAIT_L(0); PG8_MMA(0, 0, At, B0); PG8_BAR; PG8_SCHED;
            PG8_LDB(B1, 1, 1); PG8_STAGE(PG8_SB(1, 0), b3, voffB);
            PG8_BAR; PG8_WAIT_L(0); PG8_MMA(0, 1, At, B1); PG8_BAR;
            PG8_LDA(At, 1, 1); PG8_STAGE(PG8_SA(1, 0), a3, voffA);
            PG8_BAR; PG8_WAIT_L(0); PG8_MMA(1, 0, At, B0); PG8_BAR; PG8_SCHED;
            PG8_STAGE(PG8_SB(1, 1), b3 + hstep, voffB);
            PG8_WAIT_V(6); PG8_BAR; PG8_MMA(1, 1, At, B1); PG8_BAR;
        }
        PG8_STAMP();
        if constexpr (!Epi::AFTER_DRAIN) { E(acc, cur, wr, wc, fr, fq); S.done(cur); }
        PG8_STAMP();
        if (!has_next) break;
#pragma unroll
        for (int a = 0; a < 2; ++a)
#pragma unroll
            for (int b = 0; b < 2; ++b)
#pragma unroll
                for (int m = 0; m < 4; ++m)
#pragma unroll
                    for (int n = 0; n < 2; ++n) acc[a][b][m][n] = (f32x4){0.f, 0.f, 0.f, 0.f};
        cur = nxt; cA = nA; cB = nB; ++ui;
    }
    PG8_WAIT_V(0);
    if (wr == 0) PG8_BAR;
    PG8_BAR;
    if constexpr (Epi::AFTER_DRAIN) { E.fused(acc, cur, wr, wc, fr, fq, lds, wid, lane); S.done(cur); }
    PG8_STAMP();
    if (STAMP && wid == 0) { stamps[lane] = lane < nts ? (((unsigned long long)(unsigned)ts_hi << 32) | (unsigned)ts_lo) : 0ull;
        if (lane == 62) stamps[62] = rt_entry; if (lane == 63) stamps[63] = (unsigned long long)wall_clock64(); }
#undef PG8_STAMP
#undef PG8_SA
#undef PG8_SB
#undef PG8_STAGE
#undef PG8_LDA
#undef PG8_LDB
#undef PG8_MMA
#undef PG8_WAIT_V
#undef PG8_WAIT_L
#undef PG8_BAR
#undef PG8_SCHED
}
}

using pg8::Unit;
typedef f32x4 AccT[2][2][4][2];

struct EpiSwiglu {
    static constexpr bool PERM = true, AFTER_DRAIN = false;
    bf16_t* H; const float* ssq;
    DI void operator()(const AccT& acc, const Unit& u, int wr, int wc, int fr_, int fq_) const {
        int fr = fr_, fq = fq_; asm volatile("" : "+v"(fr), "+v"(fq));
        const int row0 = u.pm * 256 + wr * 64 + fr, col0 = u.pn * 128 + wc * 32 + 8 * fq;
#pragma unroll
        for (int ai = 0; ai < 2; ++ai)
#pragma unroll
            for (int m = 0; m < 4; ++m) {
                const int row = row0 + ai * 128 + m * 16;
                const float r = rsqrtf(ssq[row] * (1.0f / DM) + EPS);
                float hv[8];
#pragma unroll
                for (int n = 0; n < 2; ++n)
#pragma unroll
                    for (int j = 0; j < 4; ++j) { const float g = acc[ai][0][m][n][j] * r, up = acc[ai][1][m][n][j] * r; hv[n * 4 + j] = silu_f(g) * up; }
                u32x4 w; w.x = pk_bf16(hv[0], hv[1]); w.y = pk_bf16(hv[2], hv[3]); w.z = pk_bf16(hv[4], hv[5]); w.w = pk_bf16(hv[6], hv[7]);
                *(u32x4*)(H + (size_t)row * DFF + col0) = w;
            }
    }
};

struct EpiResid {
    static constexpr bool PERM = true, AFTER_DRAIN = false;
    const float* xa; const float* xs; float* xo; bf16_t* xb; float* ssq; float scale;
    DI void operator()(const AccT& acc, const Unit& u, int wr, int wc, int fr_, int fq_) const {
        int fr = fr_, fq = fq_; asm volatile("" : "+v"(fr), "+v"(fq));
        const int row0 = u.pm * 256 + wr * 64 + fr, col0 = u.pn * 256 + wc * 32 + 8 * fq;
        const float* src = (u.pm == 32) ? xs - (size_t)SEQ * DM : xa;
#pragma unroll
        for (int ai = 0; ai < 2; ++ai)
#pragma unroll
            for (int m = 0; m < 4; ++m) {
                const int row = row0 + ai * 128 + m * 16;
                float sq = 0.f;
#pragma unroll
                for (int bj = 0; bj < 2; ++bj) {
                    const size_t off = (size_t)row * DM + col0 + bj * 128;
                    const f32x4 x0 = *(const f32x4*)(src + off), x1 = *(const f32x4*)(src + off + 4);
                    const f32x4 y0 = x0 + acc[ai][bj][m][0] * scale, y1 = x1 + acc[ai][bj][m][1] * scale;
                    *(f32x4*)(xo + off) = y0; *(f32x4*)(xo + off + 4) = y1;
                    u32x4 w; w.x = pk_bf16(y0[0], y0[1]); w.y = pk_bf16(y0[2], y0[3]); w.z = pk_bf16(y1[0], y1[1]); w.w = pk_bf16(y1[2], y1[3]);
                    *(u32x4*)(xb + off) = w;
                    sq += (y0[0] * y0[0] + y0[1] * y0[1]) + (y0[2] * y0[2] + y0[3] * y0[3]) + (y1[0] * y1[0] + y1[1] * y1[1]) + (y1[2] * y1[2] + y1[3] * y1[3]);
                }
                sq += __shfl_xor(sq, 16); sq += __shfl_xor(sq, 32);
                if (fq == 0) atomicAdd(ssq + row, sq);
                asm volatile("" ::: "memory");
            }
    }
};

struct EpiIn {
    static constexpr bool PERM = true, AFTER_DRAIN = false;
    const float* ssq; const float* qn; const float* kn; const float* rope; float* out; unsigned char* ws; float* tbl  ;
    DI void operator()(const AccT& acc, const Unit& u, int wr, int wc, int fr_, int fq_) const {
        int fr = fr_, fq = fq_; asm volatile("" : "+v"(fr), "+v"(fq));
        const int seg = u.pn >> 2, sub = u.pn & 3;
        const bool samp = (u.pm == 32);
        const int rl0 = wr * 64 + fr;
        const int cw = wc * 32 + 8 * fq;
        if (seg <= 1) {
            float rr[2][4];
#pragma unroll
            for (int ai = 0; ai < 2; ++ai)
#pragma unroll
                for (int m = 0; m < 4; ++m) {
                    const int rl = rl0 + ai * 128 + m * 16;
                    const float r = rsqrtf(ssq[u.pm * 256 + rl] * (1.0f / DM) + EPS); rr[ai][m] = r;
#pragma unroll
                    for (int bj = 0; bj < 2; ++bj) {
                        const f32x4 a = acc[ai][bj][m][0] * r, b = acc[ai][bj][m][1] * r;
                        float s = (a[0] * a[0] + a[1] * a[1]) + (a[2] * a[2] + a[3] * a[3]) + (b[0] * b[0] + b[1] * b[1]) + (b[2] * b[2] + b[3] * b[3]);
                        s += __shfl_xor(s, 16); s += __shfl_xor(s, 32);
                        if (fq == 0) tbl[(rl * 2 + bj) * 4 + wc] = s;
                    }
                }
            asm volatile("s_waitcnt lgkmcnt(0)" ::: "memory"); __builtin_amdgcn_s_barrier(); asm volatile("" ::: "memory");
            const float* gn = seg == 0 ? qn : kn;
            const float post = seg == 0 ? 0.08838834764831845f : 1.0f;
            f32x4 g0 = *(const f32x4*)(gn + cw), g1 = *(const f32x4*)(gn + cw + 4);
            g0 *= post; g1 *= post;
            bf16_t* dstb = (bf16_t*)(ws + (seg == 0 ? WS_QB : WS_KB));
#pragma unroll
            for (int ai = 0; ai < 2; ++ai)
#pragma unroll
                for (int m = 0; m < 4; ++m) {
                    const int rl = rl0 + ai * 128 + m * 16;
#pragma unroll
                    for (int bj = 0; bj < 2; ++bj) {
                        const f32x4 t = *(const f32x4*)(tbl + (rl * 2 + bj) * 4);
                        const float hr = rsqrtf(((t[0] + t[1]) + (t[2] + t[3])) * (1.0f / 128.0f) + EPS) * rr[ai][m];
                        const f32x4 a = acc[ai][bj][m][0] * hr * g0, b = acc[ai][bj][m][1] * hr * g1;
                        const int head = sub * 2 + bj;
                        size_t idx;
                        if (!samp) idx = ((size_t)head * SEQ + (u.pm * 256 + rl)) * 128 + cw;
                        else { const int sr = rl, b_ = sr >> 4, t_ = sr & 15; idx = (size_t)8 * SEQ * 128 + (((size_t)(b_ * 8 + head)) * 16 + t_) * 128 + cw; }
                        u32x4 w; w.x = pk_bf16(a[0], a[1]); w.y = pk_bf16(a[2], a[3]); w.z = pk_bf16(b[0], b[1]); w.w = pk_bf16(b[2], b[3]);
                        *(u32x4*)(dstb + idx) = w;
                        if (seg == 1) {
                            float* o = samp ? out + O_KS + (idx - (size_t)8 * SEQ * 128) : out + O_KP + idx;
                            *(f32x4*)o = a; *(f32x4*)(o + 4) = b;
                        }
                    }
                    asm volatile("" ::: "memory");
                }
            return;
        }
#pragma unroll
        for (int ai = 0; ai < 2; ++ai)
#pragma unroll
            for (int m = 0; m < 4; ++m) {
                const int rl = rl0 + ai * 128 + m * 16, row = u.pm * 256 + rl;
                const float r = rsqrtf(ssq[row] * (1.0f / DM) + EPS);
                const int b_ = rl >> 4, t_ = rl & 15;
                if (seg == 2) {
                    bf16_t* vt = (bf16_t*)(ws + WS_VT);
#pragma unroll
                    for (int bj = 0; bj < 2; ++bj) {
                        const int head = sub * 2 + bj;
                        const f32x4 a = acc[ai][bj][m][0] * r, b = acc[ai][bj][m][1] * r;
                        if (!samp) {
                            float* o = out + O_VP + ((size_t)head * SEQ + row) * 128 + cw; *(f32x4*)o = a; *(f32x4*)(o + 4) = b;
                            bf16_t* v = vt + ((size_t)head * 128 + cw) * SEQ + row;
#pragma unroll
                            for (int j = 0; j < 4; ++j) { v[(size_t)j * SEQ] = to_bf16(a[j]); v[(size_t)(4 + j) * SEQ] = to_bf16(b[j]); }
                        } else {
                            float* o = out + O_VS + (((size_t)(b_ * 8 + head)) * 16 + t_) * 128 + cw; *(f32x4*)o = a; *(f32x4*)(o + 4) = b;
                            bf16_t* v = vt + (size_t)8 * 128 * SEQ + (((size_t)(b_ * 8 + head)) * 128 + cw) * 16 + t_;
#pragma unroll
                            for (int j = 0; j < 4; ++j) { v[j * 16] = to_bf16(a[j]); v[(4 + j) * 16] = to_bf16(b[j]); }
                        }
                    }
                } else if (seg == 3 || seg == 4) {
                    const int head = sub, pos = samp ? PAST + t_ : row;
                    const float* cs = rope + (size_t)pos * 128 + cw; const float* sn = cs + (size_t)SEQ * 128;
                    const f32x4 c0 = *(const f32x4*)cs, c1 = *(const f32x4*)(cs + 4), s0 = *(const f32x4*)sn, s1 = *(const f32x4*)(sn + 4);
                    const float sc = seg == 3 ? r : r * 0.0625f;
                    const f32x4 xa0 = acc[ai][0][m][0] * sc, xa1 = acc[ai][0][m][1] * sc, xb0 = acc[ai][1][m][0] * sc, xb1 = acc[ai][1][m][1] * sc;
                    const f32x4 lo0 = xa0 * c0 - xb0 * s0, lo1 = xa1 * c1 - xb1 * s1, hi0 = xa0 * s0 + xb0 * c0, hi1 = xa1 * s1 + xb1 * c1;
                    bf16_t* d = (bf16_t*)(ws + (seg == 3 ? WS_RQ : WS_RK));
                    const size_t idx = !samp ? ((size_t)head * SEQ + row) * 256 + cw : (size_t)4 * SEQ * 256 + (((size_t)(b_ * 4 + head)) * 16 + t_) * 256 + cw;
                    u32x4 w; w.x = pk_bf16(lo0[0], lo0[1]); w.y = pk_bf16(lo0[2], lo0[3]); w.z = pk_bf16(lo1[0], lo1[1]); w.w = pk_bf16(lo1[2], lo1[3]);
                    *(u32x4*)(d + idx) = w;
                    w.x = pk_bf16(hi0[0], hi0[1]); w.y = pk_bf16(hi0[2], hi0[3]); w.z = pk_bf16(hi1[0], hi1[1]); w.w = pk_bf16(hi1[2], hi1[3]);
                    *(u32x4*)(d + idx + 128) = w;
                    if (seg == 4) {
                        const float kd = exp2f(log2_gamma(head) * (float)(samp ? 15 - t_ : 63 - (row & 63)));
                        bf16_t* kt = (bf16_t*)(ws + WS_RKDT);
                        if (!samp) { bf16_t* v = kt + ((size_t)head * 256 + cw) * SEQ + row;
#pragma unroll
                            for (int j = 0; j < 4; ++j) { v[(size_t)j * SEQ] = to_bf16(lo0[j] * kd); v[(size_t)(4 + j) * SEQ] = to_bf16(lo1[j] * kd);
                                v[(size_t)(128 + j) * SEQ] = to_bf16(hi0[j] * kd); v[(size_t)(132 + j) * SEQ] = to_bf16(hi1[j] * kd); }
                        } else { bf16_t* v = kt + (size_t)4 * 256 * SEQ + (((size_t)(b_ * 4 + head)) * 256 + cw) * 16 + t_;
#pragma unroll
                            for (int j = 0; j < 4; ++j) { v[j * 16] = to_bf16(lo0[j] * kd); v[(4 + j) * 16] = to_bf16(lo1[j] * kd);
                                v[(128 + j) * 16] = to_bf16(hi0[j] * kd); v[(132 + j) * 16] = to_bf16(hi1[j] * kd); }
                        }
                    }
                } else if (seg == 5) {
                    const int head = sub; bf16_t* vt = (bf16_t*)(ws + WS_RVT);
#pragma unroll
                    for (int bj = 0; bj < 2; ++bj) {
                        const f32x4 a = acc[ai][bj][m][0] * r, b = acc[ai][bj][m][1] * r;
                        if (!samp) { bf16_t* v = vt + ((size_t)head * 256 + bj * 128 + cw) * SEQ + row;
#pragma unroll
                            for (int j = 0; j < 4; ++j) { v[(size_t)j * SEQ] = to_bf16(a[j]); v[(size_t)(4 + j) * SEQ] = to_bf16(b[j]); }
                        } else { bf16_t* v = vt + (size_t)4 * 256 * SEQ + (((size_t)(b_ * 4 + head)) * 256 + bj * 128 + cw) * 16 + t_;
#pragma unroll
                            for (int j = 0; j < 4; ++j) { v[j * 16] = to_bf16(a[j]); v[(4 + j) * 16] = to_bf16(b[j]); }
                        }
                    }
                } else {
                    bf16_t* g = (bf16_t*)(ws + WS_G);
#pragma unroll
                    for (int bj = 0; bj < 2; ++bj) {
                        const f32x4 a = acc[ai][bj][m][0] * r, b = acc[ai][bj][m][1] * r;
                        u32x4 w; w.x = pk_bf16(silu_f(a[0]), silu_f(a[1])); w.y = pk_bf16(silu_f(a[2]), silu_f(a[3])); w.z = pk_bf16(silu_f(b[0]), silu_f(b[1])); w.w = pk_bf16(silu_f(b[2]), silu_f(b[3]));
                        *(u32x4*)(g + (size_t)row * 1024 + sub * 256 + bj * 128 + cw) = w;
                    }
                }
                asm volatile("" ::: "memory");
            }
    }
};

#define MFMA32(a, b, c) __builtin_amdgcn_mfma_f32_32x32x16_bf16((a), (b), (c), 0, 0, 0)

struct TJob { const float* src; const float* gain; bf16_t* dst; int ld, lddst, k0, n0, mode; };
struct KP { const float* in[20]; float* out; unsigned char* ws; };
DI void tconv_load(const TJob& j, int tid, f32x4 (&v)[8]) {
    const int c4 = tid & 63, r = tid >> 6;
#pragma unroll
    for (int p = 0; p < 8; ++p) v[p] = *(const f32x4*)(j.src + (size_t)(j.k0 + r + 8 * p) * j.ld + j.n0 + c4 * 4);
}
DI void tconv_put(const TJob& j, int tid, const f32x4 (&v)[8], float* tile) {
    const int c4 = tid & 63, r = tid >> 6;
#pragma unroll
    for (int p = 0; p < 8; ++p) { f32x4 x = v[p]; if (j.gain) x *= j.gain[j.k0 + r + 8 * p]; *(f32x4*)(tile + (r + 8 * p) * 256 + ((c4 ^ p) << 2)) = x; }
}
DI void tconv_store(const TJob& j, int tid, const float* tile) {
#pragma unroll
    for (int q = 0; q < 4; ++q) {
        const int idx = tid + 512 * q, n = idx >> 3, kg = idx & 7;
        const float* t = tile + kg * 8 * 256 + (((n >> 2) ^ kg) << 2) + (n & 3);
        u32x4 w; w.x = pk_bf16(t[0], t[256]); w.y = pk_bf16(t[512], t[768]); w.z = pk_bf16(t[1024], t[1280]); w.w = pk_bf16(t[1536], t[1792]);
        const int nn = j.n0 + n, R = j.mode == 0 ? nn : 256 * (nn >> 7) + 128 * (j.mode - 1) + (nn & 127);
        *(u32x4*)(j.dst + (size_t)R * j.lddst + j.k0 + kg * 8) = w;
    }
}
constexpr int TC_GU = 32 * 22, TC_DN = 88 * 8, TC_IN = 32 * 28, TC_O = 32 * 8;
constexpr int TE1 = 2 * TC_GU, TE2 = TE1 + TC_DN, TE3 = TE2 + TC_IN, TE4 = TE3 + TC_O, TE6 = TE4 + 2 * TC_GU, TE7 = TE6 + TC_DN;
DI TJob tconv_job(const KP& p, int t) {
    TJob j; unsigned char* ws = p.ws;
    if (t < TE1 || (t >= TE4 && t < TE6)) {
        const bool second = t >= TE4; int tt = second ? t - TE4 : t; const int up = tt >= TC_GU; if (up) tt -= TC_GU;
        j.src = p.in[second ? (up ? 17 : 16) : (up ? 7 : 6)]; j.gain = p.in[second ? 15 : 5]; j.dst = (bf16_t*)(ws + (second ? WS_W2T : WS_W1T));
        j.ld = DFF; j.lddst = DM; j.k0 = (tt / 22) * 64; j.n0 = (tt % 22) * 256; j.mode = 1 + up;
    } else if (t < TE2 || t >= TE6) {
        const bool second = t >= TE6; const int tt = second ? t - TE6 : t - TE1;
        j.src = p.in[second ? 18 : 8]; j.gain = nullptr; j.dst = (bf16_t*)(ws + (second ? WS_WD2T : WS_WD1T)); j.ld = DM; j.lddst = DFF; j.k0 = (tt >> 3) * 64; j.n0 = (tt & 7) * 256; j.mode = 0;
    } else if (t < TE3) { const int tt = t - TE2;
        j.src = p.in[10]; j.gain = p.in[9]; j.dst = (bf16_t*)(ws + WS_WINT); j.ld = DIN; j.lddst = DM; j.k0 = (tt / 28) * 64; j.n0 = (tt % 28) * 256; j.mode = 0;
    } else { const int tt = t - TE3;
        j.src = p.in[14]; j.gain = nullptr; j.dst = (bf16_t*)(ws + WS_WOT); j.ld = DM; j.lddst = DM; j.k0 = (tt >> 3) * 64; j.n0 = (tt & 7) * 256; j.mode = 0;
    }
    return j;
}

DI void phase0(const KP& p, float* tile, int tid) {
    const int G = gridDim.x, bid = blockIdx.x;
    unsigned char* ws = p.ws;
    {
        f32x4 v[8]; TJob cur = tconv_job(p, bid < TE7 ? bid : 0);
        if (bid < TE7) tconv_load(cur, tid, v);
        for (int t = bid; t < TE7; t += G) {
            tconv_put(cur, tid, v, tile);
            TJob nxt = cur;
            if (t + G < TE7) { nxt = tconv_job(p, t + G); tconv_load(nxt, tid, v); }
            __syncthreads();
            tconv_store(cur, tid, tile);
            __syncthreads();
            cur = nxt;
        }
    }
    const int lane = tid & 63, wave = tid >> 6, gw = bid * 8 + wave, nw = G * 8;
    float* ssq = (float*)(ws + WS_SSQ); bf16_t* xn = (bf16_t*)(ws + WS_XN);
    for (int row = gw; row < MTOK; row += nw) {
        const float* x = row < SEQ ? p.in[0] + (size_t)row * DM : p.in[1] + (size_t)(row - SEQ) * DM;
        float sq = 0.f;
#pragma unroll
        for (int i = 0; i < 4; ++i) {
            const f32x4 a = *(const f32x4*)(x + i * 512 + lane * 8), b = *(const f32x4*)(x + i * 512 + lane * 8 + 4);
            sq += (a[0] * a[0] + a[1] * a[1]) + (a[2] * a[2] + a[3] * a[3]) + (b[0] * b[0] + b[1] * b[1]) + (b[2] * b[2] + b[3] * b[3]);
            u32x4 w; w.x = pk_bf16(a[0], a[1]); w.y = pk_bf16(a[2], a[3]); w.z = pk_bf16(b[0], b[1]); w.w = pk_bf16(b[2], b[3]);
            *(u32x4*)(xn + (size_t)row * DM + i * 512 + lane * 8) = w;
        }
#pragma unroll
        for (int o = 32; o >= 1; o >>= 1) sq += __shfl_xor(sq, o);
        if (lane == 0) { ssq[row] = sq; ssq[MTOK + row] = 0.f; ssq[2 * MTOK + row] = 0.f; ssq[3 * MTOK + row] = 0.f; }
    }
    float* rope = (float*)(ws + WS_ROPE);
    for (int e = bid * 512 + tid; e < SEQ * 128; e += G * 512) {
        const int pos = e >> 7, i = e & 127;
        const float inv = exp2f(-(float)i * (13.287712379549449f / 128.0f));
        const float ang = (float)pos * inv;
        const double rev = (double)ang * 0.15915494309189535; const float fr = (float)(rev - floor(rev));
        rope[e] = __builtin_amdgcn_cosf(fr); rope[(size_t)SEQ * 128 + e] = __builtin_amdgcn_sinf(fr);
    }
}

struct SbArgs {
    const bf16_t* q; int nq; int qpos0;
    const bf16_t* kA; const bf16_t* vtA; int ldv; int posA0, posA1;
    const float* kC; const float* vC;
    bf16_t* out;
};
DI void sb_unit(const SbArgs& a, int lane) {
    const int r = lane & 31, hl = lane >> 5;
    const int qr = r < a.nq ? r : a.nq - 1;
    bf16x8 qf[8];
#pragma unroll
    for (int ks = 0; ks < 8; ++ks) qf[ks] = *(const bf16x8*)(a.q + (size_t)qr * 128 + ks * 16 + hl * 8);
    const int qpos = a.qpos0 + qr;
    f32x16 o[4];
#pragma unroll
    for (int d = 0; d < 4; ++d)
#pragma unroll
        for (int i = 0; i < 16; ++i) o[d][i] = 0.f;
    float R = 0.f;
    for (int p0 = ((a.qpos0 + a.nq - 1) >> 5) << 5; p0 >= 0; p0 -= 32) {
        f32x16 st;
#pragma unroll
        for (int i = 0; i < 16; ++i) st[i] = 0.f;
        const bool fromA = p0 >= a.posA0;
        if (fromA) {
            int kr = p0 + r; kr = (kr < a.posA1 ? kr : a.posA1 - 1) - a.posA0;
            const bf16_t* kp = a.kA + (size_t)kr * 128 + hl * 8;
#pragma unroll
            for (int ks = 0; ks < 8; ++ks) st = MFMA32(*(const bf16x8*)(kp + ks * 16), qf[ks], st);
        } else {
            const float* kp = a.kC + (size_t)(p0 + r) * 128 + hl * 8;
#pragma unroll
            for (int ks = 0; ks < 8; ++ks) {
                const f32x4 x0 = *(const f32x4*)(kp + ks * 16), x1 = *(const f32x4*)(kp + ks * 16 + 4);
                u32x4 w; w.x = pk_bf16(x0[0], x0[1]); w.y = pk_bf16(x0[2], x0[3]); w.z = pk_bf16(x1[0], x1[1]); w.w = pk_bf16(x1[2], x1[3]);
                st = MFMA32(__builtin_bit_cast(bf16x8, w), qf[ks], st);
                if (ks & 1) asm volatile("" ::: "memory");
            }
        }
        float lk[16], gs[4], og[4], aft[4];
#pragma unroll
        for (int g = 0; g < 4; ++g) {
            gs[g] = 0.f;
#pragma unroll
            for (int e = 0; e < 4; ++e) {
                const int kpos = p0 + 8 * g + 4 * hl + e; const bool valid = kpos < qpos && kpos < a.posA1;
                const float l = valid ? -softplus_f(st[4 * g + e]) : 0.f; lk[4 * g + e] = l; gs[g] += l;
            }
            og[g] = __shfl_xor(gs[g], 32);
        }
        float tot = 0.f;
#pragma unroll
        for (int g = 3; g >= 0; --g) { aft[g] = tot; tot += gs[g] + og[g]; }
#pragma unroll
        for (int g = 0; g < 4; ++g) {
            float run = R + aft[g] + (hl == 0 ? og[g] : 0.f);
#pragma unroll
            for (int e = 3; e >= 0; --e) {
                const int kpos = p0 + 8 * g + 4 * hl + e; const bool valid = kpos < qpos && kpos < a.posA1;
                run += lk[4 * g + e];
                st[4 * g + e] = valid ? __expf(st[4 * g + e] + run) : 0.f;
            }
        }
        R += tot;
#pragma unroll
        for (int s2 = 0; s2 < 2; ++s2) {
            if (p0 + 16 * s2 < a.posA1) {
                u32x4 w; w.x = pk_bf16(st[8 * s2 + 0], st[8 * s2 + 1]); w.y = pk_bf16(st[8 * s2 + 2], st[8 * s2 + 3]); w.z = pk_bf16(st[8 * s2 + 4], st[8 * s2 + 5]); w.w = pk_bf16(st[8 * s2 + 6], st[8 * s2 + 7]);
                const bf16x8 pf = __builtin_bit_cast(bf16x8, w);
#pragma unroll
                for (int dt = 0; dt < 4; ++dt) {
                    const int d = dt * 32 + r; bf16x8 vf;
                    if (fromA) {
                        const bf16_t* vp = a.vtA + (size_t)d * a.ldv + (p0 - a.posA0) + 16 * s2 + 4 * hl;
                        const s16x4 lo = *(const s16x4*)vp, hi = *(const s16x4*)(vp + 8);
                        vf = __builtin_shufflevector(lo, hi, 0, 1, 2, 3, 4, 5, 6, 7);
                    } else {
                        const float* vp = a.vC + (size_t)(p0 + 16 * s2 + 4 * hl) * 128 + d;
                        u32x4 v; v.x = pk_bf16(vp[0], vp[128]); v.y = pk_bf16(vp[256], vp[384]); v.z = pk_bf16(vp[8 * 128], vp[9 * 128]); v.w = pk_bf16(vp[10 * 128], vp[11 * 128]);
                        vf = __builtin_bit_cast(bf16x8, v);
                    }
                    o[dt] = MFMA32(vf, pf, o[dt]);
                    asm volatile("" ::: "memory");
                }
            }
        }
        if (__ballot(R > -110.f) == 0ull) break;
    }
    if (r < a.nq) {
#pragma unroll
        for (int dt = 0; dt < 4; ++dt)
#pragma unroll
            for (int g = 0; g < 4; ++g) {
                u32x2 w; w.x = pk_bf16(o[dt][4 * g], o[dt][4 * g + 1]); w.y = pk_bf16(o[dt][4 * g + 2], o[dt][4 * g + 3]);
                *(u32x2*)(a.out + (size_t)r * DM + dt * 32 + 8 * g + 4 * hl) = w;
            }
    }
}

DI void reta_unit(const KP& p, int item, int w, int lane) {
    const int r = lane & 31, hl = lane >> 5;
    const bool samp = item >= 512;
    const bf16_t* kt = (const bf16_t*)(p.ws + WS_RKDT); const bf16_t* vt = (const bf16_t*)(p.ws + WS_RVT);
    if (!samp) {
        const int h = item >> 7, c = item & 127;
        const bf16_t* ka = kt + ((size_t)h * 256 + w * 32 + r) * SEQ + c * 64 + hl * 8;
        const bf16_t* vb = vt + ((size_t)h * 256 + r) * SEQ + c * 64 + hl * 8;
        bf16x8 A[4];
#pragma unroll
        for (int ks = 0; ks < 4; ++ks) A[ks] = *(const bf16x8*)(ka + ks * 16);
        bf16_t* o = (bf16_t*)(p.ws + WS_KVT) + (size_t)item * 65536;
#pragma unroll 1
        for (int d = 0; d < 8; ++d) {
            f32x16 acc;
#pragma unroll
            for (int i = 0; i < 16; ++i) acc[i] = 0.f;
#pragma unroll
            for (int ks = 0; ks < 4; ++ks) acc = MFMA32(A[ks], *(const bf16x8*)(vb + (size_t)d * 32 * SEQ + ks * 16), acc);
#pragma unroll
            for (int g = 0; g < 4; ++g) {
                u32x2 v; v.x = pk_bf16(acc[4 * g], acc[4 * g + 1]); v.y = pk_bf16(acc[4 * g + 2], acc[4 * g + 3]);
                *(u32x2*)(o + (size_t)(d * 32 + r) * 256 + w * 32 + 8 * g + 4 * hl) = v;
            }
        }
    } else {
        const int it = item - 512, h = it & 3;
        const bf16_t* ka = kt + (size_t)4 * 256 * SEQ + ((size_t)it * 256 + w * 32 + r) * 16 + hl * 8;
        const bf16_t* vb = vt + (size_t)4 * 256 * SEQ + ((size_t)it * 256 + r) * 16 + hl * 8;
        const bf16x8 A = *(const bf16x8*)ka;
        const float cdec = exp2f(log2_gamma(h) * 16.0f);
        const float* s0 = p.in[4] + (size_t)it * 65536; float* o = p.out + O_SS + (size_t)it * 65536;
#pragma unroll 1
        for (int d = 0; d < 8; ++d) {
            f32x16 acc;
#pragma unroll
            for (int i = 0; i < 16; ++i) acc[i] = 0.f;
            acc = MFMA32(A, *(const bf16x8*)(vb + (size_t)d * 32 * 16), acc);
#pragma unroll
            for (int i = 0; i < 16; ++i) {
                const size_t idx = (size_t)(w * 32 + (i & 3) + 8 * (i >> 2) + 4 * hl) * 256 + d * 32 + r;
                o[idx] = cdec * s0[idx] + acc[i];
            }
        }
    }
}

DI void scan_phase(const KP& p, int tid) {
    const bf16_t* kv = (const bf16_t*)(p.ws + WS_KVT); bf16_t* st = (bf16_t*)(p.ws + WS_ST);
    for (int e2 = blockIdx.x * 512 + tid; e2 < 4 * 32768; e2 += gridDim.x * 512) {
        const int h = e2 >> 15, e = (e2 & 32767) * 2;
        const float cdec = exp2f(log2_gamma(h) * 64.0f);
        float s0 = 0.f, s1 = 0.f;
        const size_t base = (size_t)h * 128 * 65536 + e;
#pragma unroll 32
        for (int c = 0; c < 128; ++c) {
            const unsigned kvv = *(const unsigned*)(kv + base + (size_t)c * 65536);
            *(unsigned*)(st + base + (size_t)c * 65536) = pk_bf16(s0, s1);
            s0 = cdec * s0 + __uint_as_float(kvv << 16); s1 = cdec * s1 + __uint_as_float(kvv & 0xffff0000u);
        }
        const int dv = e >> 8, dk = e & 255;
        float* o = p.out + O_SP + (size_t)h * 65536;
        o[(size_t)dk * 256 + dv] = s0; o[(size_t)(dk + 1) * 256 + dv] = s1;
    }
}

struct RcArgs {
    const bf16_t* q; int nq; int i0;
    const bf16_t* k; int nk;
    const bf16_t* vt; int ldv;
    const bf16_t* st;
    float l2g;
    const float* gain;
    const bf16_t* gate;
    bf16_t* out;
};
DI void retc_unit(const RcArgs& a, int lane) {
    const int r = lane & 31, hl = lane >> 5;
    const int qr = r < a.nq ? r : a.nq - 1, qi = a.i0 + qr;
    const bf16_t* qp = a.q + (size_t)qr * 256 + hl * 8;
    f32x16 acc[8];
#pragma unroll
    for (int d = 0; d < 8; ++d)
#pragma unroll
        for (int i = 0; i < 16; ++i) acc[d][i] = 0.f;
#pragma unroll 2
    for (int ks = 0; ks < 16; ++ks) {
        const bf16x8 B = *(const bf16x8*)(qp + ks * 16);
#pragma unroll
        for (int d = 0; d < 8; ++d) acc[d] = MFMA32(*(const bf16x8*)(a.st + (size_t)(d * 32 + r) * 256 + ks * 16 + hl * 8), B, acc[d]);
    }
    const float qdec = exp2f(a.l2g * (float)(qi + 1));
#pragma unroll
    for (int d = 0; d < 8; ++d)
#pragma unroll
        for (int i = 0; i < 16; ++i) acc[d][i] *= qdec;
    const int nblk = (a.i0 + a.nq + 31) >> 5;
    for (int jb = 0; jb < nblk; ++jb) {
        f32x16 st;
#pragma unroll
        for (int i = 0; i < 16; ++i) st[i] = 0.f;
        int kr = jb * 32 + r; kr = kr < a.nk ? kr : a.nk - 1;
        const bf16_t* kp = a.k + (size_t)kr * 256 + hl * 8;
#pragma unroll 4
        for (int ks = 0; ks < 16; ++ks) st = MFMA32(*(const bf16x8*)(kp + ks * 16), *(const bf16x8*)(qp + ks * 16), st);
#pragma unroll
        for (int i = 0; i < 16; ++i) {
            const int j = jb * 32 + (i & 3) + 8 * (i >> 2) + 4 * hl;
            st[i] = (j <= qi && j < a.nk) ? st[i] * exp2f(a.l2g * (float)(qi - j)) : 0.f;
        }
#pragma unroll
        for (int s2 = 0; s2 < 2; ++s2) {
            if (jb * 32 + 16 * s2 < a.nk) {
                u32x4 w; w.x = pk_bf16(st[8 * s2 + 0], st[8 * s2 + 1]); w.y = pk_bf16(st[8 * s2 + 2], st[8 * s2 + 3]); w.z = pk_bf16(st[8 * s2 + 4], st[8 * s2 + 5]); w.w = pk_bf16(st[8 * s2 + 6], st[8 * s2 + 7]);
                const bf16x8 pf = __builtin_bit_cast(bf16x8, w);
#pragma unroll
                for (int d = 0; d < 8; ++d) {
                    const bf16_t* vp = a.vt + (size_t)(d * 32 + r) * a.ldv + jb * 32 + 16 * s2 + 4 * hl;
                    const s16x4 lo = *(const s16x4*)vp, hi = *(const s16x4*)(vp + 8);
                    acc[d] = MFMA32(__builtin_shufflevector(lo, hi, 0, 1, 2, 3, 4, 5, 6, 7), pf, acc[d]);
                }
            }
        }
    }
    float ss = 0.f;
#pragma unroll
    for (int d = 0; d < 8; ++d)
#pragma unroll
        for (int i = 0; i < 16; ++i) ss += acc[d][i] * acc[d][i];
    ss += __shfl_xor(ss, 32);
    const float rs = rsqrtf(ss * (1.0f / 256.0f) + EPS);
    if (r < a.nq) {
#pragma unroll
        for (int d = 0; d < 8; ++d)
#pragma unroll
            for (int g = 0; g < 4; ++g) {
                const int dv = d * 32 + 8 * g + 4 * hl;
                const f32x4 gn = *(const f32x4*)(a.gain + dv);
                const u32x2 gt = *(const u32x2*)(a.gate + (size_t)r * 1024 + dv);
                const float g0 = __uint_as_float(gt.x << 16), g1 = __uint_as_float(gt.x & 0xffff0000u), g2 = __uint_as_float(gt.y << 16), g3 = __uint_as_float(gt.y & 0xffff0000u);
                u32x2 w; w.x = pk_bf16(acc[d][4 * g] * rs * gn[0] * g0, acc[d][4 * g + 1] * rs * gn[1] * g1); w.y = pk_bf16(acc[d][4 * g + 2] * rs * gn[2] * g2, acc[d][4 * g + 3] * rs * gn[3] * g3);
                *(u32x2*)(a.out + (size_t)r * DM + dv) = w;
            }
    }
}

#define XB_TMO      128
#define XB_XCNT(j)  (256  + 64 * (j))
#define XB_XSUB(j)  (1280 + 64 * (j))
#define XB_XGEN(j)  (2304 + 64 * (j))
#define XB_TOP      3328
#define XB_TOPGEN   3392
#define XCD_BAR_WORDS 3456
#define XB_SPIN_CAP (1u << 18)
#define XLAS __attribute__((address_space(3)))

__device__ __forceinline__ unsigned xb_ld(unsigned* p)              { return __hip_atomic_load(p, __ATOMIC_RELAXED, __HIP_MEMORY_SCOPE_AGENT); }
__device__ __forceinline__ unsigned xb_add(unsigned* p, unsigned v) { return __hip_atomic_fetch_add(p, v, __ATOMIC_RELAXED, __HIP_MEMORY_SCOPE_AGENT); }
__device__ __forceinline__ unsigned xb_xcc_id() { return (unsigned)__builtin_amdgcn_s_getreg((3 << 11) | 20) & 0xFu; }
#define XB_SPIN(cond, bar) do { unsigned _sp = 0; while (cond) { __builtin_amdgcn_s_sleep(1); \
    if ((++_sp & 255u) == 0u) { if (xb_ld(&(bar)[XB_TMO])) break; if (_sp > XB_SPIN_CAP) { atomicAdd(&(bar)[XB_TMO], 1u); break; } } } } while (0)

struct XcdBarrier {
    unsigned* bar; unsigned x;
    volatile XLAS unsigned* st;
};

__device__ __forceinline__ XcdBarrier xcd_barrier_post(unsigned* bar, volatile XLAS unsigned* st) {
    XcdBarrier b; b.bar = bar; b.x = xb_xcc_id(); b.st = st;
    if (threadIdx.x == 0) (void)xb_add(&bar[XB_XCNT(b.x)], 1u);
    return b;
}
__device__ __forceinline__ void xcd_barrier_complete(unsigned* bar, unsigned x, unsigned& nloc, unsigned& nx) {
    const unsigned G = gridDim.x * gridDim.y * gridDim.z;
    unsigned sum, cnt, mine, sp = 0u;
    for (;;) {
        sum = 0u; cnt = 0u; mine = 0u;
#pragma unroll
        for (unsigned j = 0; j < 16; ++j) { const unsigned c = xb_ld(&bar[XB_XCNT(j)]); sum += c; cnt += (c > 0u) ? 1u : 0u; mine = (j == x) ? c : mine; }
        if (sum == G) break;
        __builtin_amdgcn_s_sleep(1);
        if ((++sp & 255u) == 0u) { if (xb_ld(&bar[XB_TMO])) break; if (sp > XB_SPIN_CAP) { atomicAdd(&bar[XB_TMO], 1u); break; } }
    }
    nloc = mine > 0u ? mine : 1u; nx = cnt > 0u ? cnt : 1u;
}

__device__ __forceinline__ void xcd_barrier(const XcdBarrier& b) {
    asm volatile("s_waitcnt vmcnt(0)" ::: "memory");
    __syncthreads();
    if (threadIdx.x == 0) {
        unsigned* bar = b.bar;
        __builtin_amdgcn_s_waitcnt(0);
        unsigned nloc = b.st[0], nx = b.st[1];
        if (nloc == 0u) { xcd_barrier_complete(bar, b.x, nloc, nx); b.st[0] = nloc; b.st[1] = nx; }
        const unsigned old = xb_add(&bar[XB_XSUB(b.x)], 1u);
        const unsigned gen = old / nloc;
        if (old + 1u == (gen + 1u) * nloc) {
            __builtin_amdgcn_fence(__ATOMIC_RELEASE, "agent");
            asm volatile("s_waitcnt vmcnt(0)" ::: "memory");
            const unsigned og = xb_add(&bar[XB_TOP], 1u);
            const unsigned tg = og / nx;
            if (og + 1u == (tg + 1u) * nx) xb_add(&bar[XB_TOPGEN], 1u);
            else XB_SPIN(xb_ld(&bar[XB_TOPGEN]) == tg, bar);
            __builtin_amdgcn_fence(__ATOMIC_ACQUIRE, "agent");
            xb_add(&bar[XB_XGEN(b.x)], 1u);
            asm volatile("s_waitcnt vmcnt(0)" ::: "memory");
        } else {
            XB_SPIN(xb_ld(&bar[XB_XGEN(b.x)]) == gen, bar);
            __builtin_amdgcn_fence(__ATOMIC_ACQUIRE, "agent");
            asm volatile("s_waitcnt vmcnt(0)" ::: "memory");
        }
    }
    __syncthreads();
}


DI void skinny_resid(const bf16_t* __restrict__ A, const bf16_t* __restrict__ Bt, int K, const float* xin, float* xo, bf16_t* xb, float* ssq, float scale, float* red, int tid) {
    const int lane = tid & 63, wave = __builtin_amdgcn_readfirstlane(tid >> 6), r = lane & 31, hl = lane >> 5, ks = wave & 3, Kq = K >> 2;
    for (int pr = blockIdx.x; pr < 256; pr += gridDim.x) {
        const int T = pr * 2 + (wave >> 2), rt = T >> 6, ct = T & 63;
        const bf16_t* ap = Bt + (size_t)(ct * 32 + r) * K + ks * Kq + hl * 8;
        const bf16_t* bp = A + (size_t)(rt * 32 + r) * K + ks * Kq + hl * 8;
        f32x16 acc;
#pragma unroll
        for (int i = 0; i < 16; ++i) acc[i] = 0.f;
#pragma unroll 8
        for (int k = 0; k < Kq; k += 16) acc = MFMA32(*(const bf16x8*)(ap + k), *(const bf16x8*)(bp + k), acc);
#pragma unroll
        for (int i = 0; i < 16; ++i) red[(wave * 16 + i) * 64 + lane] = acc[i];
        __syncthreads();
        if (ks == 0) {
#pragma unroll
            for (int i = 0; i < 16; ++i) acc[i] += (red[((wave + 1) * 16 + i) * 64 + lane] + red[((wave + 2) * 16 + i) * 64 + lane]) + red[((wave + 3) * 16 + i) * 64 + lane];
            const int token = rt * 32 + r; float sq = 0.f;
#pragma unroll
            for (int g = 0; g < 4; ++g) {
                const size_t off = (size_t)token * DM + ct * 32 + 8 * g + 4 * hl;
                const f32x4 x = *(const f32x4*)(xin + off);
                f32x4 y; y[0] = x[0] + scale * acc[4 * g]; y[1] = x[1] + scale * acc[4 * g + 1]; y[2] = x[2] + scale * acc[4 * g + 2]; y[3] = x[3] + scale * acc[4 * g + 3];
                *(f32x4*)(xo + off) = y;
                u32x2 w; w.x = pk_bf16(y[0], y[1]); w.y = pk_bf16(y[2], y[3]); *(u32x2*)(xb + off) = w;
                sq += (y[0] * y[0] + y[1] * y[1]) + (y[2] * y[2] + y[3] * y[3]);
            }
            sq += __shfl_xor(sq, 32);
            if (hl == 0) atomicAdd(ssq + token, sq);
        }
        __syncthreads();
    }
}

#define REP_P0 1
#define REP_M1 1
#define REP_SC 1
#define REP_M2 1
#define REP_SK 1
#define REP_FN 1
constexpr int LDS_BYTES = pg8::STAGE_BYTES + 8192 + 16;
__global__ void __launch_bounds__(512, 2) fwd_kernel(KP p) {
    extern __shared__ __attribute__((aligned(16))) unsigned char lds[];
    cg::grid_group grid = cg::this_grid();
    if (p.ws == nullptr) grid.sync();
    if (threadIdx.x < 4) ((volatile XLAS unsigned*)((XLAS unsigned char*)lds + pg8::STAGE_BYTES + 8192))[threadIdx.x] = 0u;
    __syncthreads();
    const XcdBarrier xbar = xcd_barrier_post((unsigned*)(p.ws + WS_BAR), (volatile XLAS unsigned*)((XLAS unsigned char*)lds + pg8::STAGE_BYTES + 8192));
#define GRID_SYNC() xcd_barrier(xbar)
#define FRESH_IDS() int tid = threadIdx.x; asm volatile("" : "+v"(tid)); const int lane = tid & 63, wave = __builtin_amdgcn_readfirstlane(tid >> 6); (void)lane; (void)wave
    const int G = gridDim.x, bid = blockIdx.x;
    unsigned char* ws = p.ws;
    PG8_LAS unsigned char* l3 = (PG8_LAS unsigned char*)lds;
    float* ssq = (float*)(ws + WS_SSQ);
    bf16_t* XN = (bf16_t*)(ws + WS_XN); bf16_t* H = (bf16_t*)(ws + WS_H); float* X1 = (float*)(ws + WS_X1); bf16_t* MIX = (bf16_t*)(ws + WS_MIX);

    for (int rep = 0; rep < REP_P0; ++rep) { FRESH_IDS(); phase0(p, (float*)lds, tid); GRID_SYNC(); }
    {
        pg8::Gemm g{XN, (const bf16_t*)(ws + WS_W1T), MTOK, 2 * DFF, DM}; pg8::StaticOrder S; S.init(MTOK, 2 * DFF, G, bid);
        EpiSwiglu E{H, ssq};
        pg8::gemm_phase<EpiSwiglu, pg8::StaticOrder>(l3, g, S, E, nullptr);
    }
    GRID_SYNC();
    {
        pg8::Gemm g{H, (const bf16_t*)(ws + WS_WD1T), SEQ, DM, DFF}; pg8::StaticOrder S; S.init(SEQ, DM, G, bid);
        EpiResid E{p.in[0], p.in[1], X1, XN, ssq + MTOK, 0.5f};
        pg8::gemm_phase<EpiResid, pg8::StaticOrder>(l3, g, S, E, nullptr);
        { FRESH_IDS(); skinny_resid(H + (size_t)SEQ * DFF, (const bf16_t*)(ws + WS_WD1T), DFF, p.in[1], X1 + (size_t)SEQ * DM, XN + (size_t)SEQ * DM, ssq + MTOK + SEQ, 0.5f, (float*)lds, tid); }
        for (int rep = 1; rep < REP_SK; ++rep) { FRESH_IDS(); skinny_resid(H + (size_t)SEQ * DFF, (const bf16_t*)(ws + WS_WD1T), DFF, p.in[1], (float*)(ws + WS_KVT), (bf16_t*)(ws + WS_KVT + (size_t)8 * 1024 * 1024), (float*)(ws + WS_KVT + (size_t)16 * 1024 * 1024), 0.5f, (float*)lds, tid); }
    }
    GRID_SYNC();
    {
        pg8::Gemm g{XN, (const bf16_t*)(ws + WS_WINT), MTOK, DIN, DM}; pg8::StaticOrder S; S.init(MTOK, DIN, G, bid);
        EpiIn E{ssq + MTOK, p.in[11], p.in[12], (const float*)(ws + WS_ROPE), p.out, ws, (float*)(lds + pg8::STAGE_BYTES)};
        pg8::gemm_phase<EpiIn, pg8::StaticOrder>(l3, g, S, E, nullptr);
    }
    GRID_SYNC();
    for (int rep = 0; rep < REP_M1; ++rep) {
        FRESH_IDS();
        for (int tt = bid; tt < 256; tt += G) {
            TJob j; j.src = p.in[4] + (size_t)(tt >> 2) * 65536; j.gain = nullptr; j.dst = (bf16_t*)(ws + WS_ST) + (size_t)(512 + (tt >> 2)) * 65536; j.ld = 256; j.lddst = 256; j.k0 = (tt & 3) * 64; j.n0 = 0; j.mode = 0;
            f32x4 v[8]; tconv_load(j, tid, v); tconv_put(j, tid, v, (float*)lds); __syncthreads(); tconv_store(j, tid, (float*)lds); __syncthreads();
        }
        const int gw = bid * 8 + wave, nw = G * 8;
        constexpr int U_RA = 576 * 8, U_SBP = 8 * 256, U_SBS = 128;
        for (int u = gw; u < U_RA + U_SBP + U_SBS; u += nw) {
            if (u < U_RA) reta_unit(p, u >> 3, u & 7, lane);
            else if (u < U_RA + U_SBP) {
                const int v = u - U_RA, h = v >> 8, qb = 255 - (v & 255);
                SbArgs a; a.q = (const bf16_t*)(ws + WS_QB) + ((size_t)h * SEQ + qb * 32) * 128; a.nq = 32; a.qpos0 = qb * 32;
                a.kA = (const bf16_t*)(ws + WS_KB) + (size_t)h * SEQ * 128; a.vtA = (const bf16_t*)(ws + WS_VT) + (size_t)h * 128 * SEQ; a.ldv = SEQ; a.posA0 = 0; a.posA1 = SEQ;
                a.kC = nullptr; a.vC = nullptr; a.out = MIX + (size_t)(qb * 32) * DM + h * 128;
                sb_unit(a, lane);
            } else {
                const int bh = u - U_RA - U_SBP, b = bh >> 3, h = bh & 7;
                SbArgs a; a.q = (const bf16_t*)(ws + WS_QB) + (size_t)8 * SEQ * 128 + (size_t)bh * 16 * 128; a.nq = 16; a.qpos0 = PAST;
                a.kA = (const bf16_t*)(ws + WS_KB) + (size_t)8 * SEQ * 128 + (size_t)bh * 16 * 128; a.vtA = (const bf16_t*)(ws + WS_VT) + (size_t)8 * 128 * SEQ + (size_t)bh * 128 * 16; a.ldv = 16; a.posA0 = PAST; a.posA1 = PAST + DECS;
                a.kC = p.in[2] + (size_t)bh * PAST * 128; a.vC = p.in[3] + (size_t)bh * PAST * 128; a.out = MIX + (size_t)(SEQ + b * 16) * DM + h * 128;
                sb_unit(a, lane);
            }
        }
    }
    GRID_SYNC();
    for (int rep = 0; rep < REP_SC; ++rep) { FRESH_IDS(); scan_phase(p, tid); GRID_SYNC(); }
    for (int rep = 0; rep < REP_M2; ++rep) {
        FRESH_IDS();
        const int gw = bid * 8 + wave, nw = G * 8;
        for (int u = gw; u < 1024 + 64; u += nw) {
            RcArgs a;
            if (u < 1024) {
                const int item = u >> 1, half = u & 1, h = item >> 7, c = item & 127, tok = c * 64 + half * 32;
                a.q = (const bf16_t*)(ws + WS_RQ) + ((size_t)h * SEQ + tok) * 256; a.nq = 32; a.i0 = half * 32;
                a.k = (const bf16_t*)(ws + WS_RK) + ((size_t)h * SEQ + c * 64) * 256; a.nk = 64;
                a.vt = (const bf16_t*)(ws + WS_RVT) + (size_t)h * 256 * SEQ + c * 64; a.ldv = SEQ;
                a.st = (const bf16_t*)(ws + WS_ST) + (size_t)item * 65536; a.l2g = log2_gamma(h); a.gain = p.in[13] + h * 256;
                a.gate = (const bf16_t*)(ws + WS_G) + (size_t)tok * 1024 + h * 256; a.out = MIX + (size_t)tok * DM + 1024 + h * 256;
            } else {
                const int it = u - 1024, b = it >> 2, h = it & 3, row = SEQ + b * 16;
                a.q = (const bf16_t*)(ws + WS_RQ) + (size_t)4 * SEQ * 256 + (size_t)it * 16 * 256; a.nq = 16; a.i0 = 0;
                a.k = (const bf16_t*)(ws + WS_RK) + (size_t)4 * SEQ * 256 + (size_t)it * 16 * 256; a.nk = 16;
                a.vt = (const bf16_t*)(ws + WS_RVT) + (size_t)4 * 256 * SEQ + (size_t)it * 256 * 16; a.ldv = 16;
                a.st = (const bf16_t*)(ws + WS_ST) + (size_t)(512 + it) * 65536; a.l2g = log2_gamma(h); a.gain = p.in[13] + h * 256;
                a.gate = (const bf16_t*)(ws + WS_G) + (size_t)row * 1024 + h * 256; a.out = MIX + (size_t)row * DM + 1024 + h * 256;
            }
            retc_unit(a, lane);
        }
    }
    GRID_SYNC();
    {
        pg8::Gemm g{MIX, (const bf16_t*)(ws + WS_WOT), SEQ, DM, DM}; pg8::StaticOrder S; S.init(SEQ, DM, G, bid);
        EpiResid E{X1, X1 + (size_t)SEQ * DM, X1, XN, ssq + 2 * MTOK, 1.0f};
        pg8::gemm_phase<EpiResid, pg8::StaticOrder>(l3, g, S, E, nullptr);
        { FRESH_IDS(); skinny_resid(MIX + (size_t)SEQ * DM, (const bf16_t*)(ws + WS_WOT), DM, X1 + (size_t)SEQ * DM, X1 + (size_t)SEQ * DM, XN + (size_t)SEQ * DM, ssq + 2 * MTOK + SEQ, 1.0f, (float*)lds, tid); }
    }
    GRID_SYNC();
    {
        pg8::Gemm g{XN, (const bf16_t*)(ws + WS_W2T), MTOK, 2 * DFF, DM}; pg8::StaticOrder S; S.init(MTOK, 2 * DFF, G, bid);
        EpiSwiglu E{H, ssq + 2 * MTOK};
        pg8::gemm_phase<EpiSwiglu, pg8::StaticOrder>(l3, g, S, E, nullptr);
    }
    GRID_SYNC();
    {
        pg8::Gemm g{H, (const bf16_t*)(ws + WS_WD2T), SEQ, DM, DFF}; pg8::StaticOrder S; S.init(SEQ, DM, G, bid);
        EpiResid E{X1, X1 + (size_t)SEQ * DM, X1, XN, ssq + 3 * MTOK, 0.5f};
        pg8::gemm_phase<EpiResid, pg8::StaticOrder>(l3, g, S, E, nullptr);
        { FRESH_IDS(); skinny_resid(H + (size_t)SEQ * DFF, (const bf16_t*)(ws + WS_WD2T), DFF, X1 + (size_t)SEQ * DM, X1 + (size_t)SEQ * DM, XN + (size_t)SEQ * DM, ssq + 3 * MTOK + SEQ, 0.5f, (float*)lds, tid); }
    }
    GRID_SYNC();
    for (int rep = 0; rep < REP_FN; ++rep) {
        FRESH_IDS();
        const int gw = bid * 8 + wave, nw = G * 8; const float* fn = p.in[19];
        for (int row = gw; row < MTOK; row += nw) {
            const float rs = rsqrtf(ssq[3 * MTOK + row] * (1.0f / DM) + EPS);
            const float* x = X1 + (size_t)row * DM; float* y = p.out + O_Y + (size_t)row * DM;
#pragma unroll
            for (int i = 0; i < 8; ++i) { const int c = i * 256 + lane * 4; *(f32x4*)(y + c) = *(const f32x4*)(x + c) * rs * *(const f32x4*)(fn + c); }
        }
    }
}

extern "C" void kernel_launch(void* const* d_in, const int* in_sizes, int n_in, void* d_out, int out_size, void* d_ws, size_t ws_size, hipStream_t stream) {
    static int grid_blocks = 0;
    if (!grid_blocks) {
        if (n_in != 20 || ws_size < WS_END) { fprintf(stderr, "kernel_launch: need 20 inputs and %zu bytes of workspace (got %d, %zu)\n", (size_t)WS_END, n_in, ws_size); grid_blocks = -1; return; }
        int dev = 0, cus = 0, per_cu = 0;
        hipGetDevice(&dev);
        hipDeviceGetAttribute(&cus, hipDeviceAttributeMultiprocessorCount, dev);
        hipFuncSetAttribute((const void*)fwd_kernel, hipFuncAttributeMaxDynamicSharedMemorySize, LDS_BYTES);
        hipOccupancyMaxActiveBlocksPerMultiprocessor(&per_cu, (const void*)fwd_kernel, 512, LDS_BYTES);
        if (per_cu < 1) { fprintf(stderr, "kernel_launch: occupancy query says %d blocks per CU\n", per_cu); per_cu = 1; }
        grid_blocks = cus;
    }
    if (grid_blocks < 0) return;
    KP p{};
    for (int i = 0; i < 20; ++i) p.in[i] = (const float*)d_in[i];
    p.out = (float*)d_out; p.ws = (unsigned char*)d_ws;
    if (hipMemsetAsync((char*)d_ws + WS_BAR, 0, 16384, stream) != hipSuccess) { fprintf(stderr, "kernel_launch: memset of the barrier words failed\n"); return; }
    void* args[] = {&p};
    hipError_t e = hipLaunchCooperativeKernel((const void*)fwd_kernel, dim3(grid_blocks), dim3(512), args, LDS_BYTES, stream);
    if (e != hipSuccess) fprintf(stderr, "cooperative launch failed: %s (grid %d)\n", hipGetErrorString(e), grid_blocks);
}
```

```cpp
#include <hip/hip_runtime.h>
#include <hip/hip_cooperative_groups.h>
#include <cstdio>
namespace cg = cooperative_groups;

#define DI __device__ __forceinline__
typedef unsigned short bf16_t;
typedef short bf16x8 __attribute__((ext_vector_type(8)));
typedef short s16x4 __attribute__((ext_vector_type(4)));
typedef float f32x4 __attribute__((ext_vector_type(4)));
typedef float f32x2 __attribute__((ext_vector_type(2)));
typedef float f32x16 __attribute__((ext_vector_type(16)));
typedef unsigned u32x4 __attribute__((ext_vector_type(4)));
typedef unsigned u32x2 __attribute__((ext_vector_type(2)));

constexpr int DM = 2048, SEQ = 8192, NSAMP = 256, MTOK = SEQ + NSAMP, DFF = 5632, DIN = 7168, PAST = 2048, DECS = 16, DECB = 16;
constexpr float EPS = 1e-6f;

constexpr size_t al256(size_t x) { return (x + 255) & ~(size_t)255; }
constexpr size_t WS_W1T = 0;
constexpr size_t WS_WD1T = WS_W1T + (size_t)2 * DFF * DM * 2;
constexpr size_t WS_WINT = WS_WD1T + (size_t)DM * DFF * 2;
constexpr size_t WS_WOT = WS_WINT + (size_t)DIN * DM * 2;
constexpr size_t WS_W2T = WS_WOT + (size_t)DM * DM * 2;
constexpr size_t WS_WD2T = WS_W2T + (size_t)2 * DFF * DM * 2;
constexpr size_t WS_XN = WS_WD2T + (size_t)DM * DFF * 2;
constexpr size_t WS_H = WS_XN + (size_t)MTOK * DM * 2;
constexpr size_t WS_ST = WS_H;
constexpr size_t WS_X1 = WS_H + (size_t)MTOK * DFF * 2;
constexpr size_t WS_SSQ = WS_X1 + (size_t)MTOK * DM * 4;
constexpr size_t WS_QB = al256(WS_SSQ + (size_t)4 * MTOK * 4);
constexpr size_t SEG_B = (size_t)MTOK * 1024 * 2;
constexpr size_t WS_KB = WS_QB + SEG_B;
constexpr size_t WS_VT = WS_KB + SEG_B;
constexpr size_t WS_RQ = WS_VT + SEG_B;
constexpr size_t WS_RK = WS_RQ + SEG_B;
constexpr size_t WS_RKDT = WS_RK + SEG_B;
constexpr size_t WS_RVT = WS_RKDT + SEG_B;
constexpr size_t WS_G = WS_RVT + SEG_B;
constexpr size_t WS_MIX = WS_G + SEG_B;
constexpr size_t WS_KVT = WS_MIX + (size_t)MTOK * DM * 2;
constexpr size_t WS_ROPE = WS_KVT + (size_t)512 * 65536 * 2;
constexpr size_t WS_BAR = WS_ROPE + (size_t)2 * SEQ * 128 * 4;
constexpr size_t WS_END = WS_BAR + 16384;
static_assert((size_t)576 * 65536 * 2 <= (size_t)MTOK * DFF * 2, "ST must fit in H");

constexpr size_t O_Y = 0;
constexpr size_t O_KP = (size_t)MTOK * DM;
constexpr size_t O_VP = O_KP + (size_t)8 * SEQ * 128;
constexpr size_t O_SP = O_VP + (size_t)8 * SEQ * 128;
constexpr size_t O_KS = O_SP + (size_t)4 * 65536;
constexpr size_t O_VS = O_KS + (size_t)DECB * 8 * DECS * 128;
constexpr size_t O_SS = O_VS + (size_t)DECB * 8 * DECS * 128;

DI unsigned pk_bf16(float a, float b) {
    typedef __bf16 bf2 __attribute__((ext_vector_type(2)));
    bf2 v; v[0] = (__bf16)a; v[1] = (__bf16)b; return __builtin_bit_cast(unsigned, v);
}
DI bf16_t to_bf16(float a) { return __builtin_bit_cast(bf16_t, (__bf16)a); }
DI float silu_f(float g) { return g * __builtin_amdgcn_rcpf(1.f + __expf(-g)); }
DI float softplus_f(float z) { return fmaxf(z, 0.f) + __logf(1.f + __expf(-fabsf(z))); }
DI float log2_gamma(int h) { return __log2f(1.0f - exp2f(-5.0f - (float)h)); }

namespace pg8 {
#define PG8_LAS __attribute__((address_space(3)))
typedef unsigned short bf16_t;
typedef short bf16x8 __attribute__((ext_vector_type(8)));
typedef float f32x4 __attribute__((ext_vector_type(4)));
typedef unsigned u32x4 __attribute__((ext_vector_type(4)));
constexpr int BM = 256, BK = 64, HALF = 128, HTB = HALF * BK * 2  , STAGE_BYTES = 8 * HTB, NXCD = 8, WGM = 8;

__host__ __device__ __forceinline__ int lds_byte(int r, int c) { const int st = (r >> 4) * 2 + (c >> 5), rr = r & 15, cc = c & 31, ob = rr * 64 + cc * 2; return st * 1024 + (ob ^ (((ob >> 9) & 1) << 5)); }
__host__ __device__ __forceinline__ void stage_rc(int b, int& R, int& C) { const int st = b / 1024, sb = b % 1024, swz = sb ^ (((sb >> 9) & 1) << 5); R = (st >> 1) * 16 + swz / 64; C = (st & 1) * 32 + (swz % 64) / 2; }
__host__ __device__ __forceinline__ int perm32(int rho) { const int n = rho >> 4, i = rho & 15; return 8 * (i >> 2) + 4 * n + (i & 3); }

struct Unit { int pm, pn; };
struct Gemm { const bf16_t* A; const bf16_t* Bt; int M, N, K; };

struct StaticOrder {
    int nM, nN, nwg, G, c;
    __host__ __device__ void init(int M, int N, int G_, int c_) { nM = M / BM; nN = N / BM; nwg = nM * nN; G = G_; c = c_; }
    __host__ __device__ bool next(int i, Unit& u) const {
        const long L = (long)i * G + c; if (L >= nwg) return false;
        int wgid = (int)L; { const int q = nwg / NXCD, r = nwg % NXCD, xcd = wgid % NXCD, off = wgid / NXCD; wgid = (xcd < r ? xcd * (q + 1) : r * (q + 1) + (xcd - r) * q) + off; }
        const int nig = WGM * nN, gid = wgid / nig, fm = gid * WGM, gsz = (nM - fm) < WGM ? (nM - fm) : WGM;
        u.pm = fm + ((wgid % nig) % gsz); u.pn = (wgid % nig) / gsz; return true;
    }
    __device__ __forceinline__ void a_ready(const Unit&) const {}
    __device__ __forceinline__ void done(const Unit&) const {}
};
template <class Epi, class Sched, bool STAMP = false>
__device__ __forceinline__ void gemm_phase(PG8_LAS unsigned char* lds, const Gemm g, const Sched& S, const Epi& E, unsigned long long* stamps) {
    int tid_ = threadIdx.x; asm volatile("" : "+v"(tid_));
    const int tid = tid_, wid = __builtin_amdgcn_readfirstlane(tid >> 6), lane = tid & 63, wr = wid >> 2, wc = wid & 3, fr = lane & 15, fq = lane >> 4;
    const int K = g.K, nt = K / BK;
    int ts_lo = 0, ts_hi = 0, nts = 0; const unsigned long long rt_entry = STAMP ? (unsigned long long)wall_clock64() : 0ull;
#define PG8_STAMP() do { if (STAMP && wid == 0 && nts < 64) { const unsigned long long _c = (unsigned long long)clock64(); \
        ts_lo = (lane == nts) ? (int)(unsigned)_c : ts_lo; ts_hi = (lane == nts) ? (int)(unsigned)(_c >> 32) : ts_hi; ++nts; } } while (0)
    PG8_STAMP();
    unsigned voffA[2], voffB[2];
#pragma unroll
    for (int i = 0; i < 2; ++i) { int R, C; stage_rc(tid * 16 + i * 8192, R, C); const int Rb = Epi::PERM ? ((R & ~31) + perm32(R & 31)) : R;
        voffA[i] = (unsigned)(R * K + C) * 2u; voffB[i] = (unsigned)(Rb * K + C) * 2u; }
    const size_t kstep = (size_t)(BK * 2);
    const size_t hstep = (size_t)HALF * K * 2;
    const size_t tstep = 2 * hstep;
    const unsigned ldsw = (unsigned)wid * 1024u;
    const int aoff = lds_byte(wr * 64 + fr, fq * 8), boff = lds_byte(wc * 32 + fr, fq * 8);
#define PG8_SA(b, h) (((b) * 2 + (h)) * HTB)
#define PG8_SB(b, h) ((4 + (b) * 2 + (h)) * HTB)
#define PG8_STAGE(bufoff, gbase, voff) do { _Pragma("unroll") for (int _i = 0; _i < 2; ++_i) \
        __builtin_amdgcn_global_load_lds((const unsigned*)((const char*)(gbase) + (voff)[_i]), (PG8_LAS unsigned*)(lds + (bufoff) + ldsw + _i * 8192), 16, 0, 0); } while (0)
#define PG8_LDA(dst, b, h) do { _Pragma("unroll") for (int m = 0; m < 4; ++m) _Pragma("unroll") for (int k = 0; k < 2; ++k) dst[m][k] = *(const PG8_LAS bf16x8*)(lds + PG8_SA(b, h) + aoff + m * 2048 + k * 1024); } while (0)
#define PG8_LDB(dst, b, h) do { _Pragma("unroll") for (int n = 0; n < 2; ++n) _Pragma("unroll") for (int k = 0; k < 2; ++k) dst[n][k] = *(const PG8_LAS bf16x8*)(lds + PG8_SB(b, h) + boff + n * 2048 + k * 1024); } while (0)
#define PG8_MMA(ai, bj, At, Bt) do { __builtin_amdgcn_s_setprio(1); _Pragma("unroll") for (int m = 0; m < 4; ++m) _Pragma("unroll") for (int n = 0; n < 2; ++n) _Pragma("unroll") for (int k = 0; k < 2; ++k) \
        acc[ai][bj][m][n] = __builtin_amdgcn_mfma_f32_16x16x32_bf16(Bt[n][k], At[m][k], acc[ai][bj][m][n], 0, 0, 0); __builtin_amdgcn_s_setprio(0); } while (0)
#define PG8_WAIT_V(n) asm volatile("s_waitcnt vmcnt(" #n ")" ::: "memory")
#define PG8_WAIT_L(n) asm volatile("s_waitcnt lgkmcnt(" #n ")" ::: "memory")
#define PG8_BAR __builtin_amdgcn_s_barrier()
#define PG8_SCHED __builtin_amdgcn_sched_barrier(0)
    Unit cur, nxt; int ui = 0;
    if (!S.next(0, cur)) return;
    f32x4 acc[2][2][4][2];
#pragma unroll
    for (int a = 0; a < 2; ++a)
#pragma unroll
        for (int b = 0; b < 2; ++b)
#pragma unroll
            for (int m = 0; m < 4; ++m)
#pragma unroll
                for (int n = 0; n < 2; ++n) acc[a][b][m][n] = (f32x4){0.f, 0.f, 0.f, 0.f};
    bf16x8 At[4][2], B0[2][2], B1[2][2];
    const char* cA = (const char*)g.A + (size_t)cur.pm * tstep; const char* cB = (const char*)g.Bt + (size_t)cur.pn * tstep;
    S.a_ready(cur);
    PG8_STAGE(PG8_SB(0, 0), cB, voffB); PG8_STAGE(PG8_SA(0, 0), cA, voffA); PG8_STAGE(PG8_SB(0, 1), cB + hstep, voffB); PG8_STAGE(PG8_SA(0, 1), cA + hstep, voffA);
    if (wr == 1) PG8_BAR;
    PG8_WAIT_V(4); PG8_BAR;
    PG8_STAGE(PG8_SB(1, 0), cB + kstep, voffB); PG8_STAGE(PG8_SA(1, 0), cA + kstep, voffA); PG8_STAGE(PG8_SB(1, 1), cB + hstep + kstep, voffB);
    PG8_WAIT_V(6); PG8_BAR;
    PG8_STAMP();
    for (;;) {
        const bool has_next = S.next(ui + 1, nxt);
        const char* nA = has_next ? (const char*)g.A + (size_t)nxt.pm * tstep : cA; const char* nB = has_next ? (const char*)g.Bt + (size_t)nxt.pn * tstep : cB;
        for (int t = 0; t < nt; t += 2) {
            const bool last = (t == nt - 2);
            const char* a1 = cA + (size_t)(t + 1) * kstep;
            const char* a2 = last ? nA : cA + (size_t)(t + 2) * kstep; const char* b2 = last ? nB : cB + (size_t)(t + 2) * kstep;
            const char* a3 = a2 + kstep; const char* b3 = b2 + kstep;
            if (last && has_next) S.a_ready(nxt);
            PG8_LDB(B0, 0, 0); PG8_SCHED; PG8_LDA(At, 0, 0); PG8_STAGE(PG8_SA(1, 1), a1 + hstep, voffA);
            PG8_WAIT_L(8); PG8_BAR; PG8_WAIT_L(0); PG8_MMA(0, 0, At, B0); PG8_BAR; PG8_SCHED;
            PG8_LDB(B1, 0, 1); PG8_STAGE(PG8_SB(0, 0), b2, voffB);
            PG8_BAR; PG8_WAIT_L(0); PG8_MMA(0, 1, At, B1); PG8_BAR;
            PG8_LDA(At, 0, 1); PG8_STAGE(PG8_SA(0, 0), a2, voffA);
            PG8_BAR; PG8_WAIT_L(0); PG8_MMA(1, 0, At, B0); PG8_BAR; PG8_SCHED;
            PG8_STAGE(PG8_SB(0, 1), b2 + hstep, voffB);
            PG8_WAIT_V(6); PG8_BAR; PG8_MMA(1, 1, At, B1); PG8_BAR;
            PG8_LDB(B0, 1, 0); PG8_SCHED; PG8_LDA(At, 1, 0); PG8_STAGE(PG8_SA(0, 1), a2 + hstep, voffA);
            PG8_WAIT_L(8); PG8_BAR; PG8_WAIT_L(0); PG8_MMA(0, 0, At, B0); PG8_BAR; PG8_SCHED;
            PG8_LDB(B1, 1, 1); PG8_STAGE(PG8_SB(1, 0), b3, voffB);
            PG8_BAR; PG8_WAIT_L(0); PG8_MMA(0, 1, At, B1); PG8_BAR;
            PG8_LDA(At, 1, 1); PG8_STAGE(PG8_SA(1, 0), a3, voffA);
            PG8_BAR; PG8_WAIT_L(0); PG8_MMA(1, 0, At, B0); PG8_BAR; PG8_SCHED;
            PG8_STAGE(PG8_SB(1, 1), b3 + hstep, voffB);
            PG8_WAIT_V(6); PG8_BAR; PG8_MMA(1, 1, At, B1); PG8_BAR;
        }
        PG8_STAMP();
        if constexpr (!Epi::AFTER_DRAIN) { E(acc, cur, wr, wc, fr, fq); S.done(cur); }
        PG8_STAMP();
        if (!has_next) break;
#pragma unroll
        for (int a = 0; a < 2; ++a)
#pragma unroll
            for (int b = 0; b < 2; ++b)
#pragma unroll
                for (int m = 0; m < 4; ++m)
#pragma unroll
                    for (int n = 0; n < 2; ++n) acc[a][b][m][n] = (f32x4){0.f, 0.f, 0.f, 0.f};
        cur = nxt; cA = nA; cB = nB; ++ui;
    }
    PG8_WAIT_V(0);
    if (wr == 0) PG8_BAR;
    PG8_BAR;
    if constexpr (Epi::AFTER_DRAIN) { E.fused(acc, cur, wr, wc, fr, fq, lds, wid, lane); S.done(cur); }
    PG8_STAMP();
    if (STAMP && wid == 0) { stamps[lane] = lane < nts ? (((unsigned long long)(unsigned)ts_hi << 32) | (unsigned)ts_lo) : 0ull;
        if (lane == 62) stamps[62] = rt_entry; if (lane == 63) stamps[63] = (unsigned long long)wall_clock64(); }
#undef PG8_STAMP
#undef PG8_SA
#undef PG8_SB
#undef PG8_STAGE
#undef PG8_LDA
#undef PG8_LDB
#undef PG8_MMA
#undef PG8_WAIT_V
#undef PG8_WAIT_L
#undef PG8_BAR
#undef PG8_SCHED
}
}

using pg8::Unit;
typedef f32x4 AccT[2][2][4][2];

struct EpiSwiglu {
    static constexpr bool PERM = true, AFTER_DRAIN = false;
    bf16_t* H; const float* ssq;
    DI void operator()(const AccT& acc, const Unit& u, int wr, int wc, int fr_, int fq_) const {
        int fr = fr_, fq = fq_; asm volatile("" : "+v"(fr), "+v"(fq));
        const int row0 = u.pm * 256 + wr * 64 + fr, col0 = u.pn * 128 + wc * 32 + 8 * fq;
        float rs[2][4];
#pragma unroll
        for (int ai = 0; ai < 2; ++ai)
#pragma unroll
            for (int m = 0; m < 4; ++m) rs[ai][m] = ssq[row0 + ai * 128 + m * 16];
#pragma unroll
        for (int ai = 0; ai < 2; ++ai)
#pragma unroll
            for (int m = 0; m < 4; ++m) {
                const int row = row0 + ai * 128 + m * 16;
                const float r = rsqrtf(rs[ai][m] * (1.0f / DM) + EPS);
                float hv[8];
#pragma unroll
                for (int n = 0; n < 2; ++n)
#pragma unroll
                    for (int j = 0; j < 4; ++j) { const float g = acc[ai][0][m][n][j] * r, up = acc[ai][1][m][n][j] * r; hv[n * 4 + j] = silu_f(g) * up; }
                u32x4 w; w.x = pk_bf16(hv[0], hv[1]); w.y = pk_bf16(hv[2], hv[3]); w.z = pk_bf16(hv[4], hv[5]); w.w = pk_bf16(hv[6], hv[7]);
                *(u32x4*)(H + (size_t)row * DFF + col0) = w;
            }
    }
};

struct EpiResid {
    static constexpr bool PERM = true, AFTER_DRAIN = false;
    const float* xa; const float* xs; float* xo; bf16_t* xb; float* ssq; float scale;
    DI void operator()(const AccT& acc, const Unit& u, int wr, int wc, int fr_, int fq_) const {
        int fr = fr_, fq = fq_; asm volatile("" : "+v"(fr), "+v"(fq));
        const int row0 = u.pm * 256 + wr * 64 + fr, col0 = u.pn * 256 + wc * 32 + 8 * fq;
        const float* src = (u.pm == 32) ? xs - (size_t)SEQ * DM : xa;
#pragma unroll
        for (int ai = 0; ai < 2; ++ai) {
            f32x4 xv[4][2][2];
#pragma unroll
            for (int m = 0; m < 4; ++m)
#pragma unroll
                for (int bj = 0; bj < 2; ++bj) {
                    const size_t off = (size_t)(row0 + ai * 128 + m * 16) * DM + col0 + bj * 128;
                    xv[m][bj][0] = *(const f32x4*)(src + off); xv[m][bj][1] = *(const f32x4*)(src + off + 4);
                }
#pragma unroll
            for (int m = 0; m < 4; ++m) {
                const int row = row0 + ai * 128 + m * 16;
                float sq = 0.f;
#pragma unroll
                for (int bj = 0; bj < 2; ++bj) {
                    const size_t off = (size_t)row * DM + col0 + bj * 128;
                    const f32x4 y0 = xv[m][bj][0] + acc[ai][bj][m][0] * scale, y1 = xv[m][bj][1] + acc[ai][bj][m][1] * scale;
                    *(f32x4*)(xo + off) = y0; *(f32x4*)(xo + off + 4) = y1;
                    u32x4 w; w.x = pk_bf16(y0[0], y0[1]); w.y = pk_bf16(y0[2], y0[3]); w.z = pk_bf16(y1[0], y1[1]); w.w = pk_bf16(y1[2], y1[3]);
                    *(u32x4*)(xb + off) = w;
                    sq += (y0[0] * y0[0] + y0[1] * y0[1]) + (y0[2] * y0[2] + y0[3] * y0[3]) + (y1[0] * y1[0] + y1[1] * y1[1]) + (y1[2] * y1[2] + y1[3] * y1[3]);
                }
                sq += __shfl_xor(sq, 16); sq += __shfl_xor(sq, 32);
                if (fq == 0) atomicAdd(ssq + row, sq);
            }
            asm volatile("" ::: "memory");
        }
    }
};

struct EpiIn {
    static constexpr bool PERM = true, AFTER_DRAIN = false;
    const float* ssq; const float* qn; const float* kn; const float* rope; float* out; unsigned char* ws; float* tbl  ;
    DI void operator()(const AccT& acc, const Unit& u, int wr, int wc, int fr_, int fq_) const {
        int fr = fr_, fq = fq_; asm volatile("" : "+v"(fr), "+v"(fq));
        const int seg = u.pn >> 2, sub = u.pn & 3;
        const bool samp = (u.pm == 32);
        const int rl0 = wr * 64 + fr;
        const int cw = wc * 32 + 8 * fq;
        float rsc[2][4];
#pragma unroll
        for (int ai = 0; ai < 2; ++ai)
#pragma unroll
            for (int m = 0; m < 4; ++m) rsc[ai][m] = ssq[u.pm * 256 + rl0 + ai * 128 + m * 16];
#pragma unroll
        for (int ai = 0; ai < 2; ++ai)
#pragma unroll
            for (int m = 0; m < 4; ++m) rsc[ai][m] = rsqrtf(rsc[ai][m] * (1.0f / DM) + EPS);
        if (seg <= 1) {
            float rr[2][4];
#pragma unroll
            for (int ai = 0; ai < 2; ++ai)
#pragma unroll
                for (int m = 0; m < 4; ++m) {
                    const int rl = rl0 + ai * 128 + m * 16;
                    const float r = rsc[ai][m]; rr[ai][m] = r;
#pragma unroll
                    for (int bj = 0; bj < 2; ++bj) {
                        const f32x4 a = acc[ai][bj][m][0] * r, b = acc[ai][bj][m][1] * r;
                        float s = (a[0] * a[0] + a[1] * a[1]) + (a[2] * a[2] + a[3] * a[3]) + (b[0] * b[0] + b[1] * b[1]) + (b[2] * b[2] + b[3] * b[3]);
                        s += __shfl_xor(s, 16); s += __shfl_xor(s, 32);
                        if (fq == 0) tbl[(rl * 2 + bj) * 4 + wc] = s;
                    }
                }
            asm volatile("s_waitcnt lgkmcnt(0)" ::: "memory"); __builtin_amdgcn_s_barrier(); asm volatile("" ::: "memory");
            const float* gn = seg == 0 ? qn : kn;
            const float post = seg == 0 ? 0.08838834764831845f : 1.0f;
            f32x4 g0 = *(const f32x4*)(gn + cw), g1 = *(const f32x4*)(gn + cw + 4);
            g0 *= post; g1 *= post;
            bf16_t* dstb = (bf16_t*)(ws + (seg == 0 ? WS_QB : WS_KB));
#pragma unroll
            for (int ai = 0; ai < 2; ++ai)
#pragma unroll
                for (int m = 0; m < 4; ++m) {
                    const int rl = rl0 + ai * 128 + m * 16;
#pragma unroll
                    for (int bj = 0; bj < 2; ++bj) {
                        const f32x4 t = *(const f32x4*)(tbl + (rl * 2 + bj) * 4);
                        const float hr = rsqrtf(((t[0] + t[1]) + (t[2] + t[3])) * (1.0f / 128.0f) + EPS) * rr[ai][m];
                        const f32x4 a = acc[ai][bj][m][0] * hr * g0, b = acc[ai][bj][m][1] * hr * g1;
                        const int head = sub * 2 + bj;
                        size_t idx;
                        if (!samp) idx = ((size_t)head * SEQ + (u.pm * 256 + rl)) * 128 + cw;
                        else { const int sr = rl, b_ = sr >> 4, t_ = sr & 15; idx = (size_t)8 * SEQ * 128 + (((size_t)(b_ * 8 + head)) * 16 + t_) * 128 + cw; }
                        u32x4 w; w.x = pk_bf16(a[0], a[1]); w.y = pk_bf16(a[2], a[3]); w.z = pk_bf16(b[0], b[1]); w.w = pk_bf16(b[2], b[3]);
                        *(u32x4*)(dstb + idx) = w;
                        if (seg == 1) {
                            float* o = samp ? out + O_KS + (idx - (size_t)8 * SEQ * 128) : out + O_KP + idx;
                            *(f32x4*)o = a; *(f32x4*)(o + 4) = b;
                        }
                    }
                    asm volatile("" ::: "memory");
                }
            return;
        }
#pragma unroll
        for (int ai = 0; ai < 2; ++ai) {
#pragma unroll
            for (int m = 0; m < 4; ++m) {
                const int rl = rl0 + ai * 128 + m * 16, row = u.pm * 256 + rl;
                const float r = rsc[ai][m];
                const int b_ = rl >> 4, t_ = rl & 15;
                if (seg == 2) {
                    bf16_t* vt = (bf16_t*)(ws + WS_VT);
#pragma unroll
                    for (int bj = 0; bj < 2; ++bj) {
                        const int head = sub * 2 + bj;
                        const f32x4 a = acc[ai][bj][m][0] * r, b = acc[ai][bj][m][1] * r;
                        if (!samp) {
                            float* o = out + O_VP + ((size_t)head * SEQ + row) * 128 + cw; *(f32x4*)o = a; *(f32x4*)(o + 4) = b;
                            bf16_t* v = vt + ((size_t)head * 128 + cw) * SEQ + row;
#pragma unroll
                            for (int j = 0; j < 4; ++j) { v[(size_t)j * SEQ] = to_bf16(a[j]); v[(size_t)(4 + j) * SEQ] = to_bf16(b[j]); }
                        } else {
                            float* o = out + O_VS + (((size_t)(b_ * 8 + head)) * 16 + t_) * 128 + cw; *(f32x4*)o = a; *(f32x4*)(o + 4) = b;
                            bf16_t* v = vt + (size_t)8 * 128 * SEQ + (((size_t)(b_ * 8 + head)) * 128 + cw) * 16 + t_;
#pragma unroll
                            for (int j = 0; j < 4; ++j) { v[j * 16] = to_bf16(a[j]); v[(4 + j) * 16] = to_bf16(b[j]); }
                        }
                    }
                } else if (seg == 3 || seg == 4) {
                    const int head = sub, pos = samp ? PAST + t_ : row;
                    const float* cs = rope + (size_t)pos * 128 + cw; const float* sn = cs + (size_t)SEQ * 128;
                    const f32x4 c0 = *(const f32x4*)cs, c1 = *(const f32x4*)(cs + 4), s0 = *(const f32x4*)sn, s1 = *(const f32x4*)(sn + 4);
                    const float sc = seg == 3 ? r : r * 0.0625f;
                    const f32x4 xa0 = acc[ai][0][m][0] * sc, xa1 = acc[ai][0][m][1] * sc, xb0 = acc[ai][1][m][0] * sc, xb1 = acc[ai][1][m][1] * sc;
                    const f32x4 lo0 = xa0 * c0 - xb0 * s0, lo1 = xa1 * c1 - xb1 * s1, hi0 = xa0 * s0 + xb0 * c0, hi1 = xa1 * s1 + xb1 * c1;
                    bf16_t* d = (bf16_t*)(ws + (seg == 3 ? WS_RQ : WS_RK));
                    const size_t idx = !samp ? ((size_t)head * SEQ + row) * 256 + cw : (size_t)4 * SEQ * 256 + (((size_t)(b_ * 4 + head)) * 16 + t_) * 256 + cw;
                    u32x4 w; w.x = pk_bf16(lo0[0], lo0[1]); w.y = pk_bf16(lo0[2], lo0[3]); w.z = pk_bf16(lo1[0], lo1[1]); w.w = pk_bf16(lo1[2], lo1[3]);
                    *(u32x4*)(d + idx) = w;
                    w.x = pk_bf16(hi0[0], hi0[1]); w.y = pk_bf16(hi0[2], hi0[3]); w.z = pk_bf16(hi1[0], hi1[1]); w.w = pk_bf16(hi1[2], hi1[3]);
                    *(u32x4*)(d + idx + 128) = w;
                    if (seg == 4) {
                        const float kd = exp2f(log2_gamma(head) * (float)(samp ? 15 - t_ : 63 - (row & 63)));
                        bf16_t* kt = (bf16_t*)(ws + WS_RKDT);
                        if (!samp) { bf16_t* v = kt + ((size_t)head * 256 + cw) * SEQ + row;
#pragma unroll
                            for (int j = 0; j < 4; ++j) { v[(size_t)j * SEQ] = to_bf16(lo0[j] * kd); v[(size_t)(4 + j) * SEQ] = to_bf16(lo1[j] * kd);
                                v[(size_t)(128 + j) * SEQ] = to_bf16(hi0[j] * kd); v[(size_t)(132 + j) * SEQ] = to_bf16(hi1[j] * kd); }
                        } else { bf16_t* v = kt + (size_t)4 * 256 * SEQ + (((size_t)(b_ * 4 + head)) * 256 + cw) * 16 + t_;
#pragma unroll
                            for (int j = 0; j < 4; ++j) { v[j * 16] = to_bf16(lo0[j] * kd); v[(4 + j) * 16] = to_bf16(lo1[j] * kd);
                                v[(128 + j) * 16] = to_bf16(hi0[j] * kd); v[(132 + j) * 16] = to_bf16(hi1[j] * kd); }
                        }
                    }
                } else if (seg == 5) {
                    const int head = sub; bf16_t* vt = (bf16_t*)(ws + WS_RVT);
#pragma unroll
                    for (int bj = 0; bj < 2; ++bj) {
                        const f32x4 a = acc[ai][bj][m][0] * r, b = acc[ai][bj][m][1] * r;
                        if (!samp) { bf16_t* v = vt + ((size_t)head * 256 + bj * 128 + cw) * SEQ + row;
#pragma unroll
                            for (int j = 0; j < 4; ++j) { v[(size_t)j * SEQ] = to_bf16(a[j]); v[(size_t)(4 + j) * SEQ] = to_bf16(b[j]); }
                        } else { bf16_t* v = vt + (size_t)4 * 256 * SEQ + (((size_t)(b_ * 4 + head)) * 256 + bj * 128 + cw) * 16 + t_;
#pragma unroll
                            for (int j = 0; j < 4; ++j) { v[j * 16] = to_bf16(a[j]); v[(4 + j) * 16] = to_bf16(b[j]); }
                        }
                    }
                } else {
                    bf16_t* g = (bf16_t*)(ws + WS_G);
#pragma unroll
                    for (int bj = 0; bj < 2; ++bj) {
                        const f32x4 a = acc[ai][bj][m][0] * r, b = acc[ai][bj][m][1] * r;
                        u32x4 w; w.x = pk_bf16(silu_f(a[0]), silu_f(a[1])); w.y = pk_bf16(silu_f(a[2]), silu_f(a[3])); w.z = pk_bf16(silu_f(b[0]), silu_f(b[1])); w.w = pk_bf16(silu_f(b[2]), silu_f(b[3]));
                        *(u32x4*)(g + (size_t)row * 1024 + sub * 256 + bj * 128 + cw) = w;
                    }
                }
                asm volatile("" ::: "memory");
            }
        }
    }
};

#define MFMA32(a, b, c) __builtin_amdgcn_mfma_f32_32x32x16_bf16((a), (b), (c), 0, 0, 0)

struct TJob { const float* src; const float* gain; bf16_t* dst; int ld, lddst, k0, n0, mode; };
struct KP { const float* in[20]; float* out; unsigned char* ws; };
DI void tconv_load(const TJob& j, int tid, f32x4 (&v)[8]) {
    const int c4 = tid & 63, r = tid >> 6;
#pragma unroll
    for (int p = 0; p < 8; ++p) v[p] = *(const f32x4*)(j.src + (size_t)(j.k0 + r + 8 * p) * j.ld + j.n0 + c4 * 4);
}
DI void tconv_put(const TJob& j, int tid, const f32x4 (&v)[8], float* tile) {
    const int c4 = tid & 63, r = tid >> 6;
#pragma unroll
    for (int p = 0; p < 8; ++p) { f32x4 x = v[p]; if (j.gain) x *= j.gain[j.k0 + r + 8 * p]; *(f32x4*)(tile + (r + 8 * p) * 256 + ((c4 ^ p) << 2)) = x; }
}
DI void tconv_store(const TJob& j, int tid, const float* tile) {
#pragma unroll
    for (int q = 0; q < 4; ++q) {
        const int idx = tid + 512 * q, n = idx >> 3, kg = idx & 7;
        const float* t = tile + kg * 8 * 256 + (((n >> 2) ^ kg) << 2) + (n & 3);
        u32x4 w; w.x = pk_bf16(t[0], t[256]); w.y = pk_bf16(t[512], t[768]); w.z = pk_bf16(t[1024], t[1280]); w.w = pk_bf16(t[1536], t[1792]);
        const int nn = j.n0 + n, R = j.mode == 0 ? nn : 256 * (nn >> 7) + 128 * (j.mode - 1) + (nn & 127);
        *(u32x4*)(j.dst + (size_t)R * j.lddst + j.k0 + kg * 8) = w;
    }
}
constexpr int TC_GU = 32 * 22, TC_DN = 88 * 8, TC_IN = 32 * 28, TC_O = 32 * 8;
constexpr int TE1 = 2 * TC_GU, TE2 = TE1 + TC_DN, TE3 = TE2 + TC_IN, TE4 = TE3 + TC_O, TE6 = TE4 + 2 * TC_GU, TE7 = TE6 + TC_DN;
DI TJob tconv_job(const KP& p, int t) {
    TJob j; unsigned char* ws = p.ws;
    if (t < TE1 || (t >= TE4 && t < TE6)) {
        const bool second = t >= TE4; int tt = second ? t - TE4 : t; const int up = tt >= TC_GU; if (up) tt -= TC_GU;
        j.src = p.in[second ? (up ? 17 : 16) : (up ? 7 : 6)]; j.gain = p.in[second ? 15 : 5]; j.dst = (bf16_t*)(ws + (second ? WS_W2T : WS_W1T));
        j.ld = DFF; j.lddst = DM; j.k0 = (tt / 22) * 64; j.n0 = (tt % 22) * 256; j.mode = 1 + up;
    } else if (t < TE2 || t >= TE6) {
        const bool second = t >= TE6; const int tt = second ? t - TE6 : t - TE1;
        j.src = p.in[second ? 18 : 8]; j.gain = nullptr; j.dst = (bf16_t*)(ws + (second ? WS_WD2T : WS_WD1T)); j.ld = DM; j.lddst = DFF; j.k0 = (tt >> 3) * 64; j.n0 = (tt & 7) * 256; j.mode = 0;
    } else if (t < TE3) { const int tt = t - TE2;
        j.src = p.in[10]; j.gain = p.in[9]; j.dst = (bf16_t*)(ws + WS_WINT); j.ld = DIN; j.lddst = DM; j.k0 = (tt / 28) * 64; j.n0 = (tt % 28) * 256; j.mode = 0;
    } else { const int tt = t - TE3;
        j.src = p.in[14]; j.gain = nullptr; j.dst = (bf16_t*)(ws + WS_WOT); j.ld = DM; j.lddst = DM; j.k0 = (tt >> 3) * 64; j.n0 = (tt & 7) * 256; j.mode = 0;
    }
    return j;
}

DI void phase0(const KP& p, float* tile, int tid) {
    const int G = gridDim.x, bid = blockIdx.x;
    unsigned char* ws = p.ws;
    {
        f32x4 v[8]; TJob cur = tconv_job(p, bid < TE7 ? bid : 0);
        if (bid < TE7) tconv_load(cur, tid, v);
        for (int t = bid; t < TE7; t += G) {
            tconv_put(cur, tid, v, tile);
            TJob nxt = cur;
            if (t + G < TE7) { nxt = tconv_job(p, t + G); tconv_load(nxt, tid, v); }
            __syncthreads();
            tconv_store(cur, tid, tile);
            __syncthreads();
            cur = nxt;
        }
    }
    const int lane = tid & 63, wave = tid >> 6, gw = bid * 8 + wave, nw = G * 8;
    float* ssq = (float*)(ws + WS_SSQ); bf16_t* xn = (bf16_t*)(ws + WS_XN);
    for (int row = gw; row < MTOK; row += nw) {
        const float* x = row < SEQ ? p.in[0] + (size_t)row * DM : p.in[1] + (size_t)(row - SEQ) * DM;
        float sq = 0.f;
#pragma unroll
        for (int i = 0; i < 4; ++i) {
            const f32x4 a = *(const f32x4*)(x + i * 512 + lane * 8), b = *(const f32x4*)(x + i * 512 + lane * 8 + 4);
            sq += (a[0] * a[0] + a[1] * a[1]) + (a[2] * a[2] + a[3] * a[3]) + (b[0] * b[0] + b[1] * b[1]) + (b[2] * b[2] + b[3] * b[3]);
            u32x4 w; w.x = pk_bf16(a[0], a[1]); w.y = pk_bf16(a[2], a[3]); w.z = pk_bf16(b[0], b[1]); w.w = pk_bf16(b[2], b[3]);
            *(u32x4*)(xn + (size_t)row * DM + i * 512 + lane * 8) = w;
        }
#pragma unroll
        for (int o = 32; o >= 1; o >>= 1) sq += __shfl_xor(sq, o);
        if (lane == 0) { ssq[row] = sq; ssq[MTOK + row] = 0.f; ssq[2 * MTOK + row] = 0.f; ssq[3 * MTOK + row] = 0.f; }
    }
    float* rope = (float*)(ws + WS_ROPE);
    for (int e = bid * 512 + tid; e < SEQ * 128; e += G * 512) {
        const int pos = e >> 7, i = e & 127;
        const float inv = exp2f(-(float)i * (13.287712379549449f / 128.0f));
        const float ang = (float)pos * inv;
        const double rev = (double)ang * 0.15915494309189535; const float fr = (float)(rev - floor(rev));
        rope[e] = __builtin_amdgcn_cosf(fr); rope[(size_t)SEQ * 128 + e] = __builtin_amdgcn_sinf(fr);
    }
}

struct SbArgs {
    const bf16_t* q; int nq; int qpos0;
    const bf16_t* kA; const bf16_t* vtA; int ldv; int posA0, posA1;
    const float* kC; const float* vC;
    bf16_t* out;
};
DI void sb_unit(const SbArgs& a, int lane) {
    const int r = lane & 31, hl = lane >> 5;
    const int qr = r < a.nq ? r : a.nq - 1;
    bf16x8 qf[8];
#pragma unroll
    for (int ks = 0; ks < 8; ++ks) qf[ks] = *(const bf16x8*)(a.q + (size_t)qr * 128 + ks * 16 + hl * 8);
    const int qpos = a.qpos0 + qr;
    f32x16 o[4];
#pragma unroll
    for (int d = 0; d < 4; ++d)
#pragma unroll
        for (int i = 0; i < 16; ++i) o[d][i] = 0.f;
    float R = 0.f;
    for (int p0 = ((a.qpos0 + a.nq - 1) >> 5) << 5; p0 >= 0; p0 -= 32) {
        f32x16 st;
#pragma unroll
        for (int i = 0; i < 16; ++i) st[i] = 0.f;
        const bool fromA = p0 >= a.posA0;
        if (fromA) {
            int kr = p0 + r; kr = (kr < a.posA1 ? kr : a.posA1 - 1) - a.posA0;
            const bf16_t* kp = a.kA + (size_t)kr * 128 + hl * 8;
#pragma unroll
            for (int ks = 0; ks < 8; ++ks) st = MFMA32(*(const bf16x8*)(kp + ks * 16), qf[ks], st);
        } else {
            const float* kp = a.kC + (size_t)(p0 + r) * 128 + hl * 8;
#pragma unroll
            for (int ks = 0; ks < 8; ++ks) {
                const f32x4 x0 = *(const f32x4*)(kp + ks * 16), x1 = *(const f32x4*)(kp + ks * 16 + 4);
                u32x4 w; w.x = pk_bf16(x0[0], x0[1]); w.y = pk_bf16(x0[2], x0[3]); w.z = pk_bf16(x1[0], x1[1]); w.w = pk_bf16(x1[2], x1[3]);
                st = MFMA32(__builtin_bit_cast(bf16x8, w), qf[ks], st);
                if (ks & 1) asm volatile("" ::: "memory");
            }
        }
        float lk[16], gs[4], og[4], aft[4];
#pragma unroll
        for (int g = 0; g < 4; ++g) {
            gs[g] = 0.f;
#pragma unroll
            for (int e = 0; e < 4; ++e) {
                const int kpos = p0 + 8 * g + 4 * hl + e; const bool valid = kpos < qpos && kpos < a.posA1;
                const float l = valid ? -softplus_f(st[4 * g + e]) : 0.f; lk[4 * g + e] = l; gs[g] += l;
            }
            og[g] = __shfl_xor(gs[g], 32);
        }
        float tot = 0.f;
#pragma unroll
        for (int g = 3; g >= 0; --g) { aft[g] = tot; tot += gs[g] + og[g]; }
#pragma unroll
        for (int g = 0; g < 4; ++g) {
            float run = R + aft[g] + (hl == 0 ? og[g] : 0.f);
#pragma unroll
            for (int e = 3; e >= 0; --e) {
                const int kpos = p0 + 8 * g + 4 * hl + e; const bool valid = kpos < qpos && kpos < a.posA1;
                run += lk[4 * g + e];
                st[4 * g + e] = valid ? __expf(st[4 * g + e] + run) : 0.f;
            }
        }
        R += tot;
#pragma unroll
        for (int s2 = 0; s2 < 2; ++s2) {
            if (p0 + 16 * s2 < a.posA1) {
                u32x4 w; w.x = pk_bf16(st[8 * s2 + 0], st[8 * s2 + 1]); w.y = pk_bf16(st[8 * s2 + 2], st[8 * s2 + 3]); w.z = pk_bf16(st[8 * s2 + 4], st[8 * s2 + 5]); w.w = pk_bf16(st[8 * s2 + 6], st[8 * s2 + 7]);
                const bf16x8 pf = __builtin_bit_cast(bf16x8, w);
#pragma unroll
                for (int dt = 0; dt < 4; ++dt) {
                    const int d = dt * 32 + r; bf16x8 vf;
                    if (fromA) {
                        const bf16_t* vp = a.vtA + (size_t)d * a.ldv + (p0 - a.posA0) + 16 * s2 + 4 * hl;
                        const s16x4 lo = *(const s16x4*)vp, hi = *(const s16x4*)(vp + 8);
                        vf = __builtin_shufflevector(lo, hi, 0, 1, 2, 3, 4, 5, 6, 7);
                    } else {
                        const float* vp = a.vC + (size_t)(p0 + 16 * s2 + 4 * hl) * 128 + d;
                        u32x4 v; v.x = pk_bf16(vp[0], vp[128]); v.y = pk_bf16(vp[256], vp[384]); v.z = pk_bf16(vp[8 * 128], vp[9 * 128]); v.w = pk_bf16(vp[10 * 128], vp[11 * 128]);
                        vf = __builtin_bit_cast(bf16x8, v);
                    }
                    o[dt] = MFMA32(vf, pf, o[dt]);
                    asm volatile("" ::: "memory");
                }
            }
        }
        if (__ballot(R > -110.f) == 0ull) break;
    }
    if (r < a.nq) {
#pragma unroll
        for (int dt = 0; dt < 4; ++dt)
#pragma unroll
            for (int g = 0; g < 4; ++g) {
                u32x2 w; w.x = pk_bf16(o[dt][4 * g], o[dt][4 * g + 1]); w.y = pk_bf16(o[dt][4 * g + 2], o[dt][4 * g + 3]);
                *(u32x2*)(a.out + (size_t)r * DM + dt * 32 + 8 * g + 4 * hl) = w;
            }
    }
}

DI void reta_unit(const KP& p, int item, int w, int lane) {
    const int r = lane & 31, hl = lane >> 5;
    const bool samp = item >= 512;
    const bf16_t* kt = (const bf16_t*)(p.ws + WS_RKDT); const bf16_t* vt = (const bf16_t*)(p.ws + WS_RVT);
    if (!samp) {
        const int h = item >> 7, c = item & 127;
        const bf16_t* ka = kt + ((size_t)h * 256 + w * 32 + r) * SEQ + c * 64 + hl * 8;
        const bf16_t* vb = vt + ((size_t)h * 256 + r) * SEQ + c * 64 + hl * 8;
        bf16x8 A[4];
#pragma unroll
        for (int ks = 0; ks < 4; ++ks) A[ks] = *(const bf16x8*)(ka + ks * 16);
        bf16_t* o = (bf16_t*)(p.ws + WS_KVT) + (size_t)item * 65536;
#pragma unroll 1
        for (int d = 0; d < 8; ++d) {
            f32x16 acc;
#pragma unroll
            for (int i = 0; i < 16; ++i) acc[i] = 0.f;
#pragma unroll
            for (int ks = 0; ks < 4; ++ks) acc = MFMA32(A[ks], *(const bf16x8*)(vb + (size_t)d * 32 * SEQ + ks * 16), acc);
#pragma unroll
            for (int g = 0; g < 4; ++g) {
                u32x2 v; v.x = pk_bf16(acc[4 * g], acc[4 * g + 1]); v.y = pk_bf16(acc[4 * g + 2], acc[4 * g + 3]);
                *(u32x2*)(o + (size_t)(d * 32 + r) * 256 + w * 32 + 8 * g + 4 * hl) = v;
            }
        }
    } else {
        const int it = item - 512, h = it & 3;
        const bf16_t* ka = kt + (size_t)4 * 256 * SEQ + ((size_t)it * 256 + w * 32 + r) * 16 + hl * 8;
        const bf16_t* vb = vt + (size_t)4 * 256 * SEQ + ((size_t)it * 256 + r) * 16 + hl * 8;
        const bf16x8 A = *(const bf16x8*)ka;
        const float cdec = exp2f(log2_gamma(h) * 16.0f);
        const float* s0 = p.in[4] + (size_t)it * 65536; float* o = p.out + O_SS + (size_t)it * 65536;
#pragma unroll 1
        for (int d = 0; d < 8; ++d) {
            f32x16 acc;
#pragma unroll
            for (int i = 0; i < 16; ++i) acc[i] = 0.f;
            acc = MFMA32(A, *(const bf16x8*)(vb + (size_t)d * 32 * 16), acc);
#pragma unroll
            for (int i = 0; i < 16; ++i) {
                const size_t idx = (size_t)(w * 32 + (i & 3) + 8 * (i >> 2) + 4 * hl) * 256 + d * 32 + r;
                o[idx] = cdec * s0[idx] + acc[i];
            }
        }
    }
}

DI void scan_phase(const KP& p, int tid) {
    const bf16_t* kv = (const bf16_t*)(p.ws + WS_KVT); bf16_t* st = (bf16_t*)(p.ws + WS_ST);
    for (int e2 = blockIdx.x * 512 + tid; e2 < 4 * 32768; e2 += gridDim.x * 512) {
        const int h = e2 >> 15, e = (e2 & 32767) * 2;
        const float cdec = exp2f(log2_gamma(h) * 64.0f);
        float s0 = 0.f, s1 = 0.f;
        const size_t base = (size_t)h * 128 * 65536 + e;
#pragma unroll 32
        for (int c = 0; c < 128; ++c) {
            const unsigned kvv = *(const unsigned*)(kv + base + (size_t)c * 65536);
            *(unsigned*)(st + base + (size_t)c * 65536) = pk_bf16(s0, s1);
            s0 = cdec * s0 + __uint_as_float(kvv << 16); s1 = cdec * s1 + __uint_as_float(kvv & 0xffff0000u);
        }
        const int dv = e >> 8, dk = e & 255;
        float* o = p.out + O_SP + (size_t)h * 65536;
        o[(size_t)dk * 256 + dv] = s0; o[(size_t)(dk + 1) * 256 + dv] = s1;
    }
}

struct RcArgs {
    const bf16_t* q; int nq; int i0;
    const bf16_t* k; int nk;
    const bf16_t* vt; int ldv;
    const bf16_t* st;
    float l2g;
    const float* gain;
    const bf16_t* gate;
    bf16_t* out;
};
DI void retc_unit(const RcArgs& a, int lane) {
    const int r = lane & 31, hl = lane >> 5;
    const int qr = r < a.nq ? r : a.nq - 1, qi = a.i0 + qr;
    const bf16_t* qp = a.q + (size_t)qr * 256 + hl * 8;
    f32x16 acc[8];
#pragma unroll
    for (int d = 0; d < 8; ++d)
#pragma unroll
        for (int i = 0; i < 16; ++i) acc[d][i] = 0.f;
#pragma unroll 2
    for (int ks = 0; ks < 16; ++ks) {
        const bf16x8 B = *(const bf16x8*)(qp + ks * 16);
#pragma unroll
        for (int d = 0; d < 8; ++d) acc[d] = MFMA32(*(const bf16x8*)(a.st + (size_t)(d * 32 + r) * 256 + ks * 16 + hl * 8), B, acc[d]);
    }
    const float qdec = exp2f(a.l2g * (float)(qi + 1));
#pragma unroll
    for (int d = 0; d < 8; ++d)
#pragma unroll
        for (int i = 0; i < 16; ++i) acc[d][i] *= qdec;
    const int nblk = (a.i0 + a.nq + 31) >> 5;
    for (int jb = 0; jb < nblk; ++jb) {
        f32x16 st;
#pragma unroll
        for (int i = 0; i < 16; ++i) st[i] = 0.f;
        int kr = jb * 32 + r; kr = kr < a.nk ? kr : a.nk - 1;
        const bf16_t* kp = a.k + (size_t)kr * 256 + hl * 8;
#pragma unroll 4
        for (int ks = 0; ks < 16; ++ks) st = MFMA32(*(const bf16x8*)(kp + ks * 16), *(const bf16x8*)(qp + ks * 16), st);
#pragma unroll
        for (int i = 0; i < 16; ++i) {
            const int j = jb * 32 + (i & 3) + 8 * (i >> 2) + 4 * hl;
            st[i] = (j <= qi && j < a.nk) ? st[i] * exp2f(a.l2g * (float)(qi - j)) : 0.f;
        }
#pragma unroll
        for (int s2 = 0; s2 < 2; ++s2) {
            if (jb * 32 + 16 * s2 < a.nk) {
                u32x4 w; w.x = pk_bf16(st[8 * s2 + 0], st[8 * s2 + 1]); w.y = pk_bf16(st[8 * s2 + 2], st[8 * s2 + 3]); w.z = pk_bf16(st[8 * s2 + 4], st[8 * s2 + 5]); w.w = pk_bf16(st[8 * s2 + 6], st[8 * s2 + 7]);
                const bf16x8 pf = __builtin_bit_cast(bf16x8, w);
#pragma unroll
                for (int d = 0; d < 8; ++d) {
                    const bf16_t* vp = a.vt + (size_t)(d * 32 + r) * a.ldv + jb * 32 + 16 * s2 + 4 * hl;
                    const s16x4 lo = *(const s16x4*)vp, hi = *(const s16x4*)(vp + 8);
                    acc[d] = MFMA32(__builtin_shufflevector(lo, hi, 0, 1, 2, 3, 4, 5, 6, 7), pf, acc[d]);
                }
            }
        }
    }
    float ss = 0.f;
#pragma unroll
    for (int d = 0; d < 8; ++d)
#pragma unroll
        for (int i = 0; i < 16; ++i) ss += acc[d][i] * acc[d][i];
    ss += __shfl_xor(ss, 32);
    const float rs = rsqrtf(ss * (1.0f / 256.0f) + EPS);
    if (r < a.nq) {
#pragma unroll
        for (int d = 0; d < 8; ++d)
#pragma unroll
            for (int g = 0; g < 4; ++g) {
                const int dv = d * 32 + 8 * g + 4 * hl;
                const f32x4 gn = *(const f32x4*)(a.gain + dv);
                const u32x2 gt = *(const u32x2*)(a.gate + (size_t)r * 1024 + dv);
                const float g0 = __uint_as_float(gt.x << 16), g1 = __uint_as_float(gt.x & 0xffff0000u), g2 = __uint_as_float(gt.y << 16), g3 = __uint_as_float(gt.y & 0xffff0000u);
                u32x2 w; w.x = pk_bf16(acc[d][4 * g] * rs * gn[0] * g0, acc[d][4 * g + 1] * rs * gn[1] * g1); w.y = pk_bf16(acc[d][4 * g + 2] * rs * gn[2] * g2, acc[d][4 * g + 3] * rs * gn[3] * g3);
                *(u32x2*)(a.out + (size_t)r * DM + dv) = w;
            }
    }
}

#define XB_TMO      128
#define XB_XCNT(j)  (256  + 64 * (j))
#define XB_XSUB(j)  (1280 + 64 * (j))
#define XB_XGEN(j)  (2304 + 64 * (j))
#define XB_TOP      3328
#define XB_TOPGEN   3392
#define XCD_BAR_WORDS 3456
#define XB_SPIN_CAP (1u << 18)
#define XLAS __attribute__((address_space(3)))

__device__ __forceinline__ unsigned xb_ld(unsigned* p)              { return __hip_atomic_load(p, __ATOMIC_RELAXED, __HIP_MEMORY_SCOPE_AGENT); }
__device__ __forceinline__ unsigned xb_add(unsigned* p, unsigned v) { return __hip_atomic_fetch_add(p, v, __ATOMIC_RELAXED, __HIP_MEMORY_SCOPE_AGENT); }
__device__ __forceinline__ unsigned xb_xcc_id() { return (unsigned)__builtin_amdgcn_s_getreg((3 << 11) | 20) & 0xFu; }
#define XB_SPIN(cond, bar) do { unsigned _sp = 0; while (cond) { __builtin_amdgcn_s_sleep(1); \
    if ((++_sp & 255u) == 0u) { if (xb_ld(&(bar)[XB_TMO])) break; if (_sp > XB_SPIN_CAP) { atomicAdd(&(bar)[XB_TMO], 1u); break; } } } } while (0)

struct XcdBarrier {
    unsigned* bar; unsigned x;
    volatile XLAS unsigned* st;
};

__device__ __forceinline__ XcdBarrier xcd_barrier_post(unsigned* bar, volatile XLAS unsigned* st) {
    XcdBarrier b; b.bar = bar; b.x = xb_xcc_id(); b.st = st;
    if (threadIdx.x == 0) (void)xb_add(&bar[XB_XCNT(b.x)], 1u);
    return b;
}
__device__ __forceinline__ void xcd_barrier_complete(unsigned* bar, unsigned x, unsigned& nloc, unsigned& nx) {
    const unsigned G = gridDim.x * gridDim.y * gridDim.z;
    unsigned sum, cnt, mine, sp = 0u;
    for (;;) {
        sum = 0u; cnt = 0u; mine = 0u;
#pragma unroll
        for (unsigned j = 0; j < 16; ++j) { const unsigned c = xb_ld(&bar[XB_XCNT(j)]); sum += c; cnt += (c > 0u) ? 1u : 0u; mine = (j == x) ? c : mine; }
        if (sum == G) break;
        __builtin_amdgcn_s_sleep(1);
        if ((++sp & 255u) == 0u) { if (xb_ld(&bar[XB_TMO])) break; if (sp > XB_SPIN_CAP) { atomicAdd(&bar[XB_TMO], 1u); break; } }
    }
    nloc = mine > 0u ? mine : 1u; nx = cnt > 0u ? cnt : 1u;
}

__device__ __forceinline__ void xcd_barrier(const XcdBarrier& b) {
    asm volatile("s_waitcnt vmcnt(0)" ::: "memory");
    __syncthreads();
    if (threadIdx.x == 0) {
        unsigned* bar = b.bar;
        __builtin_amdgcn_s_waitcnt(0);
        unsigned nloc = b.st[0], nx = b.st[1];
        if (nloc == 0u) { xcd_barrier_complete(bar, b.x, nloc, nx); b.st[0] = nloc; b.st[1] = nx; }
        const unsigned old = xb_add(&bar[XB_XSUB(b.x)], 1u);
        const unsigned gen = old / nloc;
        if (old + 1u == (gen + 1u) * nloc) {
            __builtin_amdgcn_fence(__ATOMIC_RELEASE, "agent");
            asm volatile("s_waitcnt vmcnt(0)" ::: "memory");
            const unsigned og = xb_add(&bar[XB_TOP], 1u);
            const unsigned tg = og / nx;
            if (og + 1u == (tg + 1u) * nx) xb_add(&bar[XB_TOPGEN], 1u);
            else XB_SPIN(xb_ld(&bar[XB_TOPGEN]) == tg, bar);
            __builtin_amdgcn_fence(__ATOMIC_ACQUIRE, "agent");
            xb_add(&bar[XB_XGEN(b.x)], 1u);
            asm volatile("s_waitcnt vmcnt(0)" ::: "memory");
        } else {
            XB_SPIN(xb_ld(&bar[XB_XGEN(b.x)]) == gen, bar);
            __builtin_amdgcn_fence(__ATOMIC_ACQUIRE, "agent");
            asm volatile("s_waitcnt vmcnt(0)" ::: "memory");
        }
    }
    __syncthreads();
}


DI void skinny_resid(const bf16_t* __restrict__ A, const bf16_t* __restrict__ Bt, int K, const float* xin, float* xo, bf16_t* xb, float* ssq, float scale, float* red, int tid) {
    const int lane = tid & 63, wave = __builtin_amdgcn_readfirstlane(tid >> 6), r = lane & 31, hl = lane >> 5, ks = wave & 3, Kq = K >> 2;
    for (int pr = blockIdx.x; pr < 256; pr += gridDim.x) {
        const int T = pr * 2 + (wave >> 2), rt = T >> 6, ct = T & 63;
        const bf16_t* ap = Bt + (size_t)(ct * 32 + r) * K + ks * Kq + hl * 8;
        const bf16_t* bp = A + (size_t)(rt * 32 + r) * K + ks * Kq + hl * 8;
        f32x16 acc;
#pragma unroll
        for (int i = 0; i < 16; ++i) acc[i] = 0.f;
#pragma unroll 8
        for (int k = 0; k < Kq; k += 16) acc = MFMA32(*(const bf16x8*)(ap + k), *(const bf16x8*)(bp + k), acc);
#pragma unroll
        for (int i = 0; i < 16; ++i) red[(wave * 16 + i) * 64 + lane] = acc[i];
        __syncthreads();
        if (ks == 0) {
#pragma unroll
            for (int i = 0; i < 16; ++i) acc[i] += (red[((wave + 1) * 16 + i) * 64 + lane] + red[((wave + 2) * 16 + i) * 64 + lane]) + red[((wave + 3) * 16 + i) * 64 + lane];
            const int token = rt * 32 + r; float sq = 0.f;
#pragma unroll
            for (int g = 0; g < 4; ++g) {
                const size_t off = (size_t)token * DM + ct * 32 + 8 * g + 4 * hl;
                const f32x4 x = *(const f32x4*)(xin + off);
                f32x4 y; y[0] = x[0] + scale * acc[4 * g]; y[1] = x[1] + scale * acc[4 * g + 1]; y[2] = x[2] + scale * acc[4 * g + 2]; y[3] = x[3] + scale * acc[4 * g + 3];
                *(f32x4*)(xo + off) = y;
                u32x2 w; w.x = pk_bf16(y[0], y[1]); w.y = pk_bf16(y[2], y[3]); *(u32x2*)(xb + off) = w;
                sq += (y[0] * y[0] + y[1] * y[1]) + (y[2] * y[2] + y[3] * y[3]);
            }
            sq += __shfl_xor(sq, 32);
            if (hl == 0) atomicAdd(ssq + token, sq);
        }
        __syncthreads();
    }
}

#define REP_P0 1
#define REP_M1 1
#define REP_SC 1
#define REP_M2 1
#define REP_SK 1
#define REP_FN 1
constexpr int LDS_BYTES = pg8::STAGE_BYTES + 8192 + 16;
__global__ void __launch_bounds__(512, 2) fwd_kernel(KP p) {
    extern __shared__ __attribute__((aligned(16))) unsigned char lds[];
    cg::grid_group grid = cg::this_grid();
    if (p.ws == nullptr) grid.sync();
    if (threadIdx.x < 4) ((volatile XLAS unsigned*)((XLAS unsigned char*)lds + pg8::STAGE_BYTES + 8192))[threadIdx.x] = 0u;
    __syncthreads();
    const XcdBarrier xbar = xcd_barrier_post((unsigned*)(p.ws + WS_BAR), (volatile XLAS unsigned*)((XLAS unsigned char*)lds + pg8::STAGE_BYTES + 8192));
#define GRID_SYNC() xcd_barrier(xbar)
#define FRESH_IDS() int tid = threadIdx.x; asm volatile("" : "+v"(tid)); const int lane = tid & 63, wave = __builtin_amdgcn_readfirstlane(tid >> 6); (void)lane; (void)wave
    const int G = gridDim.x, bid = blockIdx.x;
    unsigned char* ws = p.ws;
    PG8_LAS unsigned char* l3 = (PG8_LAS unsigned char*)lds;
    float* ssq = (float*)(ws + WS_SSQ);
    bf16_t* XN = (bf16_t*)(ws + WS_XN); bf16_t* H = (bf16_t*)(ws + WS_H); float* X1 = (float*)(ws + WS_X1); bf16_t* MIX = (bf16_t*)(ws + WS_MIX);

    for (int rep = 0; rep < REP_P0; ++rep) { FRESH_IDS(); phase0(p, (float*)lds, tid); GRID_SYNC(); }
    {
        pg8::Gemm g{XN, (const bf16_t*)(ws + WS_W1T), MTOK, 2 * DFF, DM}; pg8::StaticOrder S; S.init(MTOK, 2 * DFF, G, bid);
        EpiSwiglu E{H, ssq};
        pg8::gemm_phase<EpiSwiglu, pg8::StaticOrder>(l3, g, S, E, nullptr);
    }
    GRID_SYNC();
    {
        pg8::Gemm g{H, (const bf16_t*)(ws + WS_WD1T), SEQ, DM, DFF}; pg8::StaticOrder S; S.init(SEQ, DM, G, bid);
        EpiResid E{p.in[0], p.in[1], X1, XN, ssq + MTOK, 0.5f};
        pg8::gemm_phase<EpiResid, pg8::StaticOrder>(l3, g, S, E, nullptr);
        { FRESH_IDS(); skinny_resid(H + (size_t)SEQ * DFF, (const bf16_t*)(ws + WS_WD1T), DFF, p.in[1], X1 + (size_t)SEQ * DM, XN + (size_t)SEQ * DM, ssq + MTOK + SEQ, 0.5f, (float*)lds, tid); }
        for (int rep = 1; rep < REP_SK; ++rep) { FRESH_IDS(); skinny_resid(H + (size_t)SEQ * DFF, (const bf16_t*)(ws + WS_WD1T), DFF, p.in[1], (float*)(ws + WS_KVT), (bf16_t*)(ws + WS_KVT + (size_t)8 * 1024 * 1024), (float*)(ws + WS_KVT + (size_t)16 * 1024 * 1024), 0.5f, (float*)lds, tid); }
    }
    GRID_SYNC();
    {
        pg8::Gemm g{XN, (const bf16_t*)(ws + WS_WINT), MTOK, DIN, DM}; pg8::StaticOrder S; S.init(MTOK, DIN, G, bid);
        EpiIn E{ssq + MTOK, p.in[11], p.in[12], (const float*)(ws + WS_ROPE), p.out, ws, (float*)(lds + pg8::STAGE_BYTES)};
        pg8::gemm_phase<EpiIn, pg8::StaticOrder>(l3, g, S, E, nullptr);
    }
    GRID_SYNC();
    for (int rep = 0; rep < REP_M1; ++rep) {
        FRESH_IDS();
        for (int tt = bid; tt < 256; tt += G) {
            TJob j; j.src = p.in[4] + (size_t)(tt >> 2) * 65536; j.gain = nullptr; j.dst = (bf16_t*)(ws + WS_ST) + (size_t)(512 + (tt >> 2)) * 65536; j.ld = 256; j.lddst = 256; j.k0 = (tt & 3) * 64; j.n0 = 0; j.mode = 0;
            f32x4 v[8]; tconv_load(j, tid, v); tconv_put(j, tid, v, (float*)lds); __syncthreads(); tconv_store(j, tid, (float*)lds); __syncthreads();
        }
        const int gw = bid * 8 + wave, nw = G * 8;
        constexpr int U_RA = 576 * 8, U_SBP = 8 * 256, U_SBS = 128;
        for (int u = gw; u < U_RA + U_SBP + U_SBS; u += nw) {
            if (u < U_RA) reta_unit(p, u >> 3, u & 7, lane);
            else if (u < U_RA + U_SBP) {
                const int v = u - U_RA, h = v >> 8, qb = 255 - (v & 255);
                SbArgs a; a.q = (const bf16_t*)(ws + WS_QB) + ((size_t)h * SEQ + qb * 32) * 128; a.nq = 32; a.qpos0 = qb * 32;
                a.kA = (const bf16_t*)(ws + WS_KB) + (size_t)h * SEQ * 128; a.vtA = (const bf16_t*)(ws + WS_VT) + (size_t)h * 128 * SEQ; a.ldv = SEQ; a.posA0 = 0; a.posA1 = SEQ;
                a.kC = nullptr; a.vC = nullptr; a.out = MIX + (size_t)(qb * 32) * DM + h * 128;
                sb_unit(a, lane);
            } else {
                const int bh = u - U_RA - U_SBP, b = bh >> 3, h = bh & 7;
                SbArgs a; a.q = (const bf16_t*)(ws + WS_QB) + (size_t)8 * SEQ * 128 + (size_t)bh * 16 * 128; a.nq = 16; a.qpos0 = PAST;
                a.kA = (const bf16_t*)(ws + WS_KB) + (size_t)8 * SEQ * 128 + (size_t)bh * 16 * 128; a.vtA = (const bf16_t*)(ws + WS_VT) + (size_t)8 * 128 * SEQ + (size_t)bh * 128 * 16; a.ldv = 16; a.posA0 = PAST; a.posA1 = PAST + DECS;
                a.kC = p.in[2] + (size_t)bh * PAST * 128; a.vC = p.in[3] + (size_t)bh * PAST * 128; a.out = MIX + (size_t)(SEQ + b * 16) * DM + h * 128;
                sb_unit(a, lane);
            }
        }
    }
    GRID_SYNC();
    for (int rep = 0; rep < REP_SC; ++rep) { FRESH_IDS(); scan_phase(p, tid); GRID_SYNC(); }
    for (int rep = 0; rep < REP_M2; ++rep) {
        FRESH_IDS();
        const int gw = bid * 8 + wave, nw = G * 8;
        for (int u = gw; u < 1024 + 64; u += nw) {
            RcArgs a;
            if (u < 1024) {
                const int item = u >> 1, half = u & 1, h = item >> 7, c = item & 127, tok = c * 64 + half * 32;
                a.q = (const bf16_t*)(ws + WS_RQ) + ((size_t)h * SEQ + tok) * 256; a.nq = 32; a.i0 = half * 32;
                a.k = (const bf16_t*)(ws + WS_RK) + ((size_t)h * SEQ + c * 64) * 256; a.nk = 64;
                a.vt = (const bf16_t*)(ws + WS_RVT) + (size_t)h * 256 * SEQ + c * 64; a.ldv = SEQ;
                a.st = (const bf16_t*)(ws + WS_ST) + (size_t)item * 65536; a.l2g = log2_gamma(h); a.gain = p.in[13] + h * 256;
                a.gate = (const bf16_t*)(ws + WS_G) + (size_t)tok * 1024 + h * 256; a.out = MIX + (size_t)tok * DM + 1024 + h * 256;
            } else {
                const int it = u - 1024, b = it >> 2, h = it & 3, row = SEQ + b * 16;
                a.q = (const bf16_t*)(ws + WS_RQ) + (size_t)4 * SEQ * 256 + (size_t)it * 16 * 256; a.nq = 16; a.i0 = 0;
                a.k = (const bf16_t*)(ws + WS_RK) + (size_t)4 * SEQ * 256 + (size_t)it * 16 * 256; a.nk = 16;
                a.vt = (const bf16_t*)(ws + WS_RVT) + (size_t)4 * 256 * SEQ + (size_t)it * 256 * 16; a.ldv = 16;
                a.st = (const bf16_t*)(ws + WS_ST) + (size_t)(512 + it) * 65536; a.l2g = log2_gamma(h); a.gain = p.in[13] + h * 256;
                a.gate = (const bf16_t*)(ws + WS_G) + (size_t)row * 1024 + h * 256; a.out = MIX + (size_t)row * DM + 1024 + h * 256;
            }
            retc_unit(a, lane);
        }
    }
    GRID_SYNC();
    {
        pg8::Gemm g{MIX, (const bf16_t*)(ws + WS_WOT), SEQ, DM, DM}; pg8::StaticOrder S; S.init(SEQ, DM, G, bid);
        EpiResid E{X1, X1 + (size_t)SEQ * DM, X1, XN, ssq + 2 * MTOK, 1.0f};
        pg8::gemm_phase<EpiResid, pg8::StaticOrder>(l3, g, S, E, nullptr);
        { FRESH_IDS(); skinny_resid(MIX + (size_t)SEQ * DM, (const bf16_t*)(ws + WS_WOT), DM, X1 + (size_t)SEQ * DM, X1 + (size_t)SEQ * DM, XN + (size_t)SEQ * DM, ssq + 2 * MTOK + SEQ, 1.0f, (float*)lds, tid); }
    }
    GRID_SYNC();
    {
        pg8::Gemm g{XN, (const bf16_t*)(ws + WS_W2T), MTOK, 2 * DFF, DM}; pg8::StaticOrder S; S.init(MTOK, 2 * DFF, G, bid);
        EpiSwiglu E{H, ssq + 2 * MTOK};
        pg8::gemm_phase<EpiSwiglu, pg8::StaticOrder>(l3, g, S, E, nullptr);
    }
    GRID_SYNC();
    {
        pg8::Gemm g{H, (const bf16_t*)(ws + WS_WD2T), SEQ, DM, DFF}; pg8::StaticOrder S; S.init(SEQ, DM, G, bid);
        EpiResid E{X1, X1 + (size_t)SEQ * DM, X1, XN, ssq + 3 * MTOK, 0.5f};
        pg8::gemm_phase<EpiResid, pg8::StaticOrder>(l3, g, S, E, nullptr);
        { FRESH_IDS(); skinny_resid(H + (size_t)SEQ * DFF, (const bf16_t*)(ws + WS_WD2T), DFF, X1 + (size_t)SEQ * DM, X1 + (size_t)SEQ * DM, XN + (size_t)SEQ * DM, ssq + 3 * MTOK + SEQ, 0.5f, (float*)lds, tid); }
    }
    GRID_SYNC();
    for (int rep = 0; rep < REP_FN; ++rep) {
        FRESH_IDS();
        const int gw = bid * 8 + wave, nw = G * 8; const float* fn = p.in[19];
        for (int row = gw; row < MTOK; row += nw) {
            const float rs = rsqrtf(ssq[3 * MTOK + row] * (1.0f / DM) + EPS);
            const float* x = X1 + (size_t)row * DM; float* y = p.out + O_Y + (size_t)row * DM;
#pragma unroll
            for (int i = 0; i < 8; ++i) { const int c = i * 256 + lane * 4; *(f32x4*)(y + c) = *(const f32x4*)(x + c) * rs * *(const f32x4*)(fn + c); }
        }
    }
}

extern "C" void kernel_launch(void* const* d_in, const int* in_sizes, int n_in, void* d_out, int out_size, void* d_ws, size_t ws_size, hipStream_t stream) {
    static int grid_blocks = 0;
    if (!grid_blocks) {
        if (n_in != 20 || ws_size < WS_END) { fprintf(stderr, "kernel_launch: need 20 inputs and %zu bytes of workspace (got %d, %zu)\n", (size_t)WS_END, n_in, ws_size); grid_blocks = -1; return; }
        int dev = 0, cus = 0, per_cu = 0;
        hipGetDevice(&dev);
        hipDeviceGetAttribute(&cus, hipDeviceAttributeMultiprocessorCount, dev);
        hipFuncSetAttribute((const void*)fwd_kernel, hipFuncAttributeMaxDynamicSharedMemorySize, LDS_BYTES);
        hipOccupancyMaxActiveBlocksPerMultiprocessor(&per_cu, (const void*)fwd_kernel, 512, LDS_BYTES);
        if (per_cu < 1) { fprintf(stderr, "kernel_launch: occupancy query says %d blocks per CU\n", per_cu); per_cu = 1; }
        grid_blocks = cus;
    }
    if (grid_blocks < 0) return;
    KP p{};
    for (int i = 0; i < 20; ++i) p.in[i] = (const float*)d_in[i];
    p.out = (float*)d_out; p.ws = (unsigned char*)d_ws;
    if (hipMemsetAsync((char*)d_ws + WS_BAR, 0, 16384, stream) != hipSuccess) { fprintf(stderr, "kernel_launch: memset of the barrier words failed\n"); return; }
    void* args[] = {&p};
    hipError_t e = hipLaunchCooperativeKernel((const void*)fwd_kernel, dim3(grid_blocks), dim3(512), args, LDS_BYTES, stream);
    if (e != hipSuccess) fprintf(stderr, "cooperative launch failed: %s (grid %d)\n", hipGetErrorString(e), grid_blocks);
}
```

```cpp
#include <hip/hip_runtime.h>
#include <hip/hip_cooperative_groups.h>
#include <cstdio>
namespace cg = cooperative_groups;

#define DI __device__ __forceinline__
typedef unsigned short bf16_t;
typedef short bf16x8 __attribute__((ext_vector_type(8)));
typedef short s16x4 __attribute__((ext_vector_type(4)));
typedef float f32x4 __attribute__((ext_vector_type(4)));
typedef float f32x2 __attribute__((ext_vector_type(2)));
typedef float f32x16 __attribute__((ext_vector_type(16)));
typedef unsigned u32x4 __attribute__((ext_vector_type(4)));
typedef unsigned u32x2 __attribute__((ext_vector_type(2)));

constexpr int DM = 2048, SEQ = 8192, NSAMP = 256, MTOK = SEQ + NSAMP, DFF = 5632, DIN = 7168, PAST = 2048, DECS = 16, DECB = 16;
constexpr float EPS = 1e-6f;

constexpr size_t al256(size_t x) { return (x + 255) & ~(size_t)255; }
constexpr size_t WS_W1T = 0;
constexpr size_t WS_WD1T = WS_W1T + (size_t)2 * DFF * DM * 2;
constexpr size_t WS_WINT = WS_WD1T + (size_t)DM * DFF * 2;
constexpr size_t WS_WOT = WS_WINT + (size_t)DIN * DM * 2;
constexpr size_t WS_W2T = WS_WOT + (size_t)DM * DM * 2;
constexpr size_t WS_WD2T = WS_W2T + (size_t)2 * DFF * DM * 2;
constexpr size_t WS_XN = WS_WD2T + (size_t)DM * DFF * 2;
constexpr size_t WS_H = WS_XN + (size_t)MTOK * DM * 2;
constexpr size_t WS_ST = WS_H;
constexpr size_t WS_X1 = WS_H + (size_t)MTOK * DFF * 2;
constexpr size_t WS_SSQ = WS_X1 + (size_t)MTOK * DM * 4;
constexpr size_t WS_QB = al256(WS_SSQ + (size_t)4 * MTOK * 4);
constexpr size_t SEG_B = (size_t)MTOK * 1024 * 2;
constexpr size_t WS_KB = WS_QB + SEG_B;
constexpr size_t WS_VT = WS_KB + SEG_B;
constexpr size_t WS_RQ = WS_VT + SEG_B;
constexpr size_t WS_RK = WS_RQ + SEG_B;
constexpr size_t WS_RKDT = WS_RK + SEG_B;
constexpr size_t WS_RVT = WS_RKDT + SEG_B;
constexpr size_t WS_G = WS_RVT + SEG_B;
constexpr size_t WS_MIX = WS_G + SEG_B;
constexpr size_t WS_KVT = WS_MIX + (size_t)MTOK * DM * 2;
constexpr size_t WS_ROPE = WS_KVT + (size_t)512 * 65536 * 2;
constexpr size_t WS_BAR = WS_ROPE + (size_t)2 * SEQ * 128 * 4;
constexpr size_t WS_END = WS_BAR + 16384;
static_assert((size_t)576 * 65536 * 2 <= (size_t)MTOK * DFF * 2, "ST must fit in H");

constexpr size_t O_Y = 0;
constexpr size_t O_KP = (size_t)MTOK * DM;
constexpr size_t O_VP = O_KP + (size_t)8 * SEQ * 128;
constexpr size_t O_SP = O_VP + (size_t)8 * SEQ * 128;
constexpr size_t O_KS = O_SP + (size_t)4 * 65536;
constexpr size_t O_VS = O_KS + (size_t)DECB * 8 * DECS * 128;
constexpr size_t O_SS = O_VS + (size_t)DECB * 8 * DECS * 128;

DI unsigned pk_bf16(float a, float b) {
    typedef __bf16 bf2 __attribute__((ext_vector_type(2)));
    bf2 v; v[0] = (__bf16)a; v[1] = (__bf16)b; return __builtin_bit_cast(unsigned, v);
}
DI bf16_t to_bf16(float a) { return __builtin_bit_cast(bf16_t, (__bf16)a); }
DI float silu_f(float g) { return g * __builtin_amdgcn_rcpf(1.f + __expf(-g)); }
DI float softplus_f(float z) { return fmaxf(z, 0.f) + __logf(1.f + __expf(-fabsf(z))); }
DI float log2_gamma(int h) { return __log2f(1.0f - exp2f(-5.0f - (float)h)); }

namespace pg8 {
#define PG8_LAS __attribute__((address_space(3)))
typedef unsigned short bf16_t;
typedef short bf16x8 __attribute__((ext_vector_type(8)));
typedef float f32x4 __attribute__((ext_vector_type(4)));
typedef unsigned u32x4 __attribute__((ext_vector_type(4)));
constexpr int BM = 256, BK = 64, HALF = 128, HTB = HALF * BK * 2  , STAGE_BYTES = 8 * HTB, NXCD = 8, WGM = 8;

__host__ __device__ __forceinline__ int lds_byte(int r, int c) { const int st = (r >> 4) * 2 + (c >> 5), rr = r & 15, cc = c & 31, ob = rr * 64 + cc * 2; return st * 1024 + (ob ^ (((ob >> 9) & 1) << 5)); }
__host__ __device__ __forceinline__ void stage_rc(int b, int& R, int& C) { const int st = b / 1024, sb = b % 1024, swz = sb ^ (((sb >> 9) & 1) << 5); R = (st >> 1) * 16 + swz / 64; C = (st & 1) * 32 + (swz % 64) / 2; }
__host__ __device__ __forceinline__ int perm32(int rho) { const int n = rho >> 4, i = rho & 15; return 8 * (i >> 2) + 4 * n + (i & 3); }

struct Unit { int pm, pn; };
struct Gemm { const bf16_t* A; const bf16_t* Bt; int M, N, K; };

struct StaticOrder {
    int nM, nN, nwg, G, c;
    __host__ __device__ void init(int M, int N, int G_, int c_) { nM = M / BM; nN = N / BM; nwg = nM * nN; G = G_; c = c_; }
    __host__ __device__ bool next(int i, Unit& u) const {
        const long L = (long)i * G + c; if (L >= nwg) return false;
        int wgid = (int)L; { const int q = nwg / NXCD, r = nwg % NXCD, xcd = wgid % NXCD, off = wgid / NXCD; wgid = (xcd < r ? xcd * (q + 1) : r * (q + 1) + (xcd - r) * q) + off; }
        const int nig = WGM * nN, gid = wgid / nig, fm = gid * WGM, gsz = (nM - fm) < WGM ? (nM - fm) : WGM;
        u.pm = fm + ((wgid % nig) % gsz); u.pn = (wgid % nig) / gsz; return true;
    }
    __device__ __forceinline__ void a_ready(const Unit&) const {}
    __device__ __forceinline__ void done(const Unit&) const {}
};
template <class Epi, class Sched, bool STAMP = false>
__device__ __forceinline__ void gemm_phase(PG8_LAS unsigned char* lds, const Gemm g, const Sched& S, const Epi& E, unsigned long long* stamps) {
    int tid_ = threadIdx.x; asm volatile("" : "+v"(tid_));
    const int tid = tid_, wid = __builtin_amdgcn_readfirstlane(tid >> 6), lane = tid & 63, wr = wid >> 2, wc = wid & 3, fr = lane & 15, fq = lane >> 4;
    const int K = g.K, nt = K / BK;
    int ts_lo = 0, ts_hi = 0, nts = 0; const unsigned long long rt_entry = STAMP ? (unsigned long long)wall_clock64() : 0ull;
#define PG8_STAMP() do { if (STAMP && wid == 0 && nts < 64) { const unsigned long long _c = (unsigned long long)clock64(); \
        ts_lo = (lane == nts) ? (int)(unsigned)_c : ts_lo; ts_hi = (lane == nts) ? (int)(unsigned)(_c >> 32) : ts_hi; ++nts; } } while (0)
    PG8_STAMP();
    unsigned voffA[2], voffB[2];
#pragma unroll
    for (int i = 0; i < 2; ++i) { int R, C; stage_rc(tid * 16 + i * 8192, R, C); const int Rb = Epi::PERM ? ((R & ~31) + perm32(R & 31)) : R;
        voffA[i] = (unsigned)(R * K + C) * 2u; voffB[i] = (unsigned)(Rb * K + C) * 2u; }
    const size_t kstep = (size_t)(BK * 2);
    const size_t hstep = (size_t)HALF * K * 2;
    const size_t tstep = 2 * hstep;
    const unsigned ldsw = (unsigned)wid * 1024u;
    const int aoff = lds_byte(wr * 64 + fr, fq * 8), boff = lds_byte(wc * 32 + fr, fq * 8);
#define PG8_SA(b, h) (((b) * 2 + (h)) * HTB)
#define PG8_SB(b, h) ((4 + (b) * 2 + (h)) * HTB)
#define PG8_STAGE(bufoff, gbase, voff) do { _Pragma("unroll") for (int _i = 0; _i < 2; ++_i) \
        __builtin_amdgcn_global_load_lds((const unsigned*)((const char*)(gbase) + (voff)[_i]), (PG8_LAS unsigned*)(lds + (bufoff) + ldsw + _i * 8192), 16, 0, 0); } while (0)
#define PG8_LDA(dst, b, h) do { _Pragma("unroll") for (int m = 0; m < 4; ++m) _Pragma("unroll") for (int k = 0; k < 2; ++k) dst[m][k] = *(const PG8_LAS bf16x8*)(lds + PG8_SA(b, h) + aoff + m * 2048 + k * 1024); } while (0)
#define PG8_LDB(dst, b, h) do { _Pragma("unroll") for (int n = 0; n < 2; ++n) _Pragma("unroll") for (int k = 0; k < 2; ++k) dst[n][k] = *(const PG8_LAS bf16x8*)(lds + PG8_SB(b, h) + boff + n * 2048 + k * 1024); } while (0)
#define PG8_MMA(ai, bj, At, Bt) do { __builtin_amdgcn_s_setprio(1); _Pragma("unroll") for (int m = 0; m < 4; ++m) _Pragma("unroll") for (int n = 0; n < 2; ++n) _Pragma("unroll") for (int k = 0; k < 2; ++k) \
        acc[ai][bj][m][n] = __builtin_amdgcn_mfma_f32_16x16x32_bf16(Bt[n][k], At[m][k], acc[ai][bj][m][n], 0, 0, 0); __builtin_amdgcn_s_setprio(0); } while (0)
#define PG8_WAIT_V(n) asm volatile("s_waitcnt vmcnt(" #n ")" ::: "memory")
#define PG8_WAIT_L(n) asm volatile("s_waitcnt lgkmcnt(" #n ")" ::: "memory")
#define PG8_BAR __builtin_amdgcn_s_barrier()
#define PG8_SCHED __builtin_amdgcn_sched_barrier(0)
    Unit cur, nxt; int ui = 0;
    if (!S.next(0, cur)) return;
    f32x4 acc[2][2][4][2];
#pragma unroll
    for (int a = 0; a < 2; ++a)
#pragma unroll
        for (int b = 0; b < 2; ++b)
#pragma unroll
            for (int m = 0; m < 4; ++m)
#pragma unroll
                for (int n = 0; n < 2; ++n) acc[a][b][m][n] = (f32x4){0.f, 0.f, 0.f, 0.f};
    bf16x8 At[4][2], B0[2][2], B1[2][2];
    const char* cA = (const char*)g.A + (size_t)cur.pm * tstep; const char* cB = (const char*)g.Bt + (size_t)cur.pn * tstep;
    S.a_ready(cur);
    PG8_STAGE(PG8_SB(0, 0), cB, voffB); PG8_STAGE(PG8_SA(0, 0), cA, voffA); PG8_STAGE(PG8_SB(0, 1), cB + hstep, voffB); PG8_STAGE(PG8_SA(0, 1), cA + hstep, voffA);
    if (wr == 1) PG8_BAR;
    PG8_WAIT_V(4); PG8_BAR;
    PG8_STAGE(PG8_SB(1, 0), cB + kstep, voffB); PG8_STAGE(PG8_SA(1, 0), cA + kstep, voffA); PG8_STAGE(PG8_SB(1, 1), cB + hstep + kstep, voffB);
    PG8_WAIT_V(6); PG8_BAR;
    PG8_STAMP();
    for (;;) {
        const bool has_next = S.next(ui + 1, nxt);
        const char* nA = has_next ? (const char*)g.A + (size_t)nxt.pm * tstep : cA; const char* nB = has_next ? (const char*)g.Bt + (size_t)nxt.pn * tstep : cB;
        for (int t = 0; t < nt; t += 2) {
            const bool last = (t == nt - 2);
            const char* a1 = cA + (size_t)(t + 1) * kstep;
            const char* a2 = last ? nA : cA + (size_t)(t + 2) * kstep; const char* b2 = last ? nB : cB + (size_t)(t + 2) * kstep;
            const char* a3 = a2 + kstep; const char* b3 = b2 + kstep;
            if (last && has_next) S.a_ready(nxt);
            PG8_LDB(B0, 0, 0); PG8_SCHED; PG8_LDA(At, 0, 0); PG8_STAGE(PG8_SA(1, 1), a1 + hstep, voffA);
            PG8_WAIT_L(8); PG8_BAR; PG8_WAIT_L(0); PG8_MMA(0, 0, At, B0); PG8_BAR; PG8_SCHED;
            PG8_LDB(B1, 0, 1); PG8_STAGE(PG8_SB(0, 0), b2, voffB);
            PG8_BAR; PG8_WAIT_L(0); PG8_MMA(0, 1, At, B1); PG8_BAR;
            PG8_LDA(At, 0, 1); PG8_STAGE(PG8_SA(0, 0), a2, voffA);
            PG8_BAR; PG8_WAIT_L(0); PG8_MMA(1, 0, At, B0); PG8_BAR; PG8_SCHED;
            PG8_STAGE(PG8_SB(0, 1), b2 + hstep, voffB);
            PG8_WAIT_V(6); PG8_BAR; PG8_MMA(1, 1, At, B1); PG8_BAR;
            PG8_LDB(B0, 1, 0); PG8_SCHED; PG8_LDA(At, 1, 0); PG8_STAGE(PG8_SA(0, 1), a2 + hstep, voffA);
            PG8_WAIT_L(8); PG8_BAR; PG8_WAIT_L(0); PG8_MMA(0, 0, At, B0); PG8_BAR; PG8_SCHED;
            PG8_LDB(B1, 1, 1); PG8_STAGE(PG8_SB(1, 0), b3, voffB);
            PG8_BAR; PG8_WAIT_L(0); PG8_MMA(0, 1, At, B1); PG8_BAR;
            PG8_LDA(At, 1, 1); PG8_STAGE(PG8_SA(1, 0), a3, voffA);
            PG8_BAR; PG8_WAIT_L(0); PG8_MMA(1, 0, At, B0); PG8_BAR; PG8_SCHED;
            PG8_STAGE(PG8_SB(1, 1), b3 + hstep, voffB);
            PG8_WAIT_V(6); PG8_BAR; PG8_MMA(1, 1, At, B1); PG8_BAR;
        }
        PG8_STAMP();
        if constexpr (!Epi::AFTER_DRAIN) { E(acc, cur, wr, wc, fr, fq); S.done(cur); }
        PG8_STAMP();
        if (!has_next) break;
#pragma unroll
        for (int a = 0; a < 2; ++a)
#pragma unroll
            for (int b = 0; b < 2; ++b)
#pragma unroll
                for (int m = 0; m < 4; ++m)
#pragma unroll
                    for (int n = 0; n < 2; ++n) acc[a][b][m][n] = (f32x4){0.f, 0.f, 0.f, 0.f};
        cur = nxt; cA = nA; cB = nB; ++ui;
    }
    PG8_WAIT_V(0);
    if (wr == 0) PG8_BAR;
    PG8_BAR;
    if constexpr (Epi::AFTER_DRAIN) { E.fused(acc, cur, wr, wc, fr, fq, lds, wid, lane); S.done(cur); }
    PG8_STAMP();
    if (STAMP && wid == 0) { stamps[lane] = lane < nts ? (((unsigned long long)(unsigned)ts_hi << 32) | (unsigned)ts_lo) : 0ull;
        if (lane == 62) stamps[62] = rt_entry; if (lane == 63) stamps[63] = (unsigned long long)wall_clock64(); }
#undef PG8_STAMP
#undef PG8_SA
#undef PG8_SB
#undef PG8_STAGE
#undef PG8_LDA
#undef PG8_LDB
#undef PG8_MMA
#undef PG8_WAIT_V
#undef PG8_WAIT_L
#undef PG8_BAR
#undef PG8_SCHED
}
}

using pg8::Unit;
typedef f32x4 AccT[2][2][4][2];

struct EpiSwiglu {
    static constexpr bool PERM = true, AFTER_DRAIN = false;
    bf16_t* H; const float* ssq;
    DI void operator()(const AccT& acc, const Unit& u, int wr, int wc, int fr_, int fq_) const {
        int fr = fr_, fq = fq_; asm volatile("" : "+v"(fr), "+v"(fq));
        const int row0 = u.pm * 256 + wr * 64 + fr, col0 = u.pn * 128 + wc * 32 + 8 * fq;
        float rs[2][4];
#pragma unroll
        for (int ai = 0; ai < 2; ++ai)
#pragma unroll
            for (int m = 0; m < 4; ++m) rs[ai][m] = ssq[row0 + ai * 128 + m * 16];
#pragma unroll
        for (int ai = 0; ai < 2; ++ai)
#pragma unroll
            for (int m = 0; m < 4; ++m) {
                const int row = row0 + ai * 128 + m * 16;
                const float r = rsqrtf(rs[ai][m] * (1.0f / DM) + EPS);
                float hv[8];
#pragma unroll
                for (int n = 0; n < 2; ++n)
#pragma unroll
                    for (int j = 0; j < 4; ++j) { const float g = acc[ai][0][m][n][j] * r, up = acc[ai][1][m][n][j] * r; hv[n * 4 + j] = silu_f(g) * up; }
                u32x4 w; w.x = pk_bf16(hv[0], hv[1]); w.y = pk_bf16(hv[2], hv[3]); w.z = pk_bf16(hv[4], hv[5]); w.w = pk_bf16(hv[6], hv[7]);
                *(u32x4*)(H + (size_t)row * DFF + col0) = w;
            }
    }
};

struct EpiResid {
    static constexpr bool PERM = true, AFTER_DRAIN = false;
    const float* xa; const float* xs; float* xo; bf16_t* xb; float* ssq; float scale;
    DI void operator()(const AccT& acc, const Unit& u, int wr, int wc, int fr_, int fq_) const {
        int fr = fr_, fq = fq_; asm volatile("" : "+v"(fr), "+v"(fq));
        const int row0 = u.pm * 256 + wr * 64 + fr, col0 = u.pn * 256 + wc * 32 + 8 * fq;
        const float* src = (u.pm == 32) ? xs - (size_t)SEQ * DM : xa;
#pragma unroll
        for (int ai = 0; ai < 2; ++ai) {
            f32x4 xv[4][2][2];
#pragma unroll
            for (int m = 0; m < 4; ++m)
#pragma unroll
                for (int bj = 0; bj < 2; ++bj) {
                    const size_t off = (size_t)(row0 + ai * 128 + m * 16) * DM + col0 + bj * 128;
                    xv[m][bj][0] = *(const f32x4*)(src + off); xv[m][bj][1] = *(const f32x4*)(src + off + 4);
                }
#pragma unroll
            for (int m = 0; m < 4; ++m) {
                const int row = row0 + ai * 128 + m * 16;
                float sq = 0.f;
#pragma unroll
                for (int bj = 0; bj < 2; ++bj) {
                    const size_t off = (size_t)row * DM + col0 + bj * 128;
                    const f32x4 y0 = xv[m][bj][0] + acc[ai][bj][m][0] * scale, y1 = xv[m][bj][1] + acc[ai][bj][m][1] * scale;
                    *(f32x4*)(xo + off) = y0; *(f32x4*)(xo + off + 4) = y1;
                    u32x4 w; w.x = pk_bf16(y0[0], y0[1]); w.y = pk_bf16(y0[2], y0[3]); w.z = pk_bf16(y1[0], y1[1]); w.w = pk_bf16(y1[2], y1[3]);
                    *(u32x4*)(xb + off) = w;
                    sq += (y0[0] * y0[0] + y0[1] * y0[1]) + (y0[2] * y0[2] + y0[3] * y0[3]) + (y1[0] * y1[0] + y1[1] * y1[1]) + (y1[2] * y1[2] + y1[3] * y1[3]);
                }
                sq += __shfl_xor(sq, 16); sq += __shfl_xor(sq, 32);
                if (fq == 0) atomicAdd(ssq + row, sq);
            }
            asm volatile("" ::: "memory");
        }
    }
};

struct EpiIn {
    static constexpr bool PERM = true, AFTER_DRAIN = false;
    const float* ssq; const float* qn; const float* kn; const float* rope; float* out; unsigned char* ws; float* tbl  ;
    DI void operator()(const AccT& acc, const Unit& u, int wr, int wc, int fr_, int fq_) const {
        int fr = fr_, fq = fq_; asm volatile("" : "+v"(fr), "+v"(fq));
        const int seg = u.pn >> 2, sub = u.pn & 3;
        const bool samp = (u.pm == 32);
        const int rl0 = wr * 64 + fr;
        const int cw = wc * 32 + 8 * fq;
        float rsc[2][4];
#pragma unroll
        for (int ai = 0; ai < 2; ++ai)
#pragma unroll
            for (int m = 0; m < 4; ++m) rsc[ai][m] = ssq[u.pm * 256 + rl0 + ai * 128 + m * 16];
#pragma unroll
        for (int ai = 0; ai < 2; ++ai)
#pragma unroll
            for (int m = 0; m < 4; ++m) rsc[ai][m] = rsqrtf(rsc[ai][m] * (1.0f / DM) + EPS);
        if (seg <= 1) {
            float rr[2][4];
#pragma unroll
            for (int ai = 0; ai < 2; ++ai)
#pragma unroll
                for (int m = 0; m < 4; ++m) {
                    const int rl = rl0 + ai * 128 + m * 16;
                    const float r = rsc[ai][m]; rr[ai][m] = r;
#pragma unroll
                    for (int bj = 0; bj < 2; ++bj) {
                        const f32x4 a = acc[ai][bj][m][0] * r, b = acc[ai][bj][m][1] * r;
                        float s = (a[0] * a[0] + a[1] * a[1]) + (a[2] * a[2] + a[3] * a[3]) + (b[0] * b[0] + b[1] * b[1]) + (b[2] * b[2] + b[3] * b[3]);
                        s += __shfl_xor(s, 16); s += __shfl_xor(s, 32);
                        if (fq == 0) tbl[(rl * 2 + bj) * 4 + wc] = s;
                    }
                }
            asm volatile("s_waitcnt lgkmcnt(0)" ::: "memory"); __builtin_amdgcn_s_barrier(); asm volatile("" ::: "memory");
            const float* gn = seg == 0 ? qn : kn;
            const float post = seg == 0 ? 0.08838834764831845f : 1.0f;
            f32x4 g0 = *(const f32x4*)(gn + cw), g1 = *(const f32x4*)(gn + cw + 4);
            g0 *= post; g1 *= post;
            bf16_t* dstb = (bf16_t*)(ws + (seg == 0 ? WS_QB : WS_KB));
#pragma unroll
            for (int ai = 0; ai < 2; ++ai)
#pragma unroll
                for (int m = 0; m < 4; ++m) {
                    const int rl = rl0 + ai * 128 + m * 16;
#pragma unroll
                    for (int bj = 0; bj < 2; ++bj) {
                        const f32x4 t = *(const f32x4*)(tbl + (rl * 2 + bj) * 4);
                        const float hr = rsqrtf(((t[0] + t[1]) + (t[2] + t[3])) * (1.0f / 128.0f) + EPS) * rr[ai][m];
                        const f32x4 a = acc[ai][bj][m][0] * hr * g0, b = acc[ai][bj][m][1] * hr * g1;
                        const int head = sub * 2 + bj;
                        size_t idx;
                        if (!samp) idx = ((size_t)head * SEQ + (u.pm * 256 + rl)) * 128 + cw;
                        else { const int sr = rl, b_ = sr >> 4, t_ = sr & 15; idx = (size_t)8 * SEQ * 128 + (((size_t)(b_ * 8 + head)) * 16 + t_) * 128 + cw; }
                        u32x4 w; w.x = pk_bf16(a[0], a[1]); w.y = pk_bf16(a[2], a[3]); w.z = pk_bf16(b[0], b[1]); w.w = pk_bf16(b[2], b[3]);
                        *(u32x4*)(dstb + idx) = w;
                        if (seg == 1) {
                            float* o = samp ? out + O_KS + (idx - (size_t)8 * SEQ * 128) : out + O_KP + idx;
                            *(f32x4*)o = a; *(f32x4*)(o + 4) = b;
                        }
                    }
                    asm volatile("" ::: "memory");
                }
            return;
        }
#pragma unroll
        for (int ai = 0; ai < 2; ++ai) {
#pragma unroll
            for (int m = 0; m < 4; ++m) {
                const int rl = rl0 + ai * 128 + m * 16, row = u.pm * 256 + rl;
                const float r = rsc[ai][m];
                const int b_ = rl >> 4, t_ = rl & 15;
                if (seg == 2) {
                    bf16_t* vt = (bf16_t*)(ws + WS_VT);
#pragma unroll
                    for (int bj = 0; bj < 2; ++bj) {
                        const int head = sub * 2 + bj;
                        const f32x4 a = acc[ai][bj][m][0] * r, b = acc[ai][bj][m][1] * r;
                        if (!samp) {
                            float* o = out + O_VP + ((size_t)head * SEQ + row) * 128 + cw; *(f32x4*)o = a; *(f32x4*)(o + 4) = b;
                            bf16_t* v = vt + ((size_t)head * 128 + cw) * SEQ + row;
#pragma unroll
                            for (int j = 0; j < 4; ++j) { v[(size_t)j * SEQ] = to_bf16(a[j]); v[(size_t)(4 + j) * SEQ] = to_bf16(b[j]); }
                        } else {
                            float* o = out + O_VS + (((size_t)(b_ * 8 + head)) * 16 + t_) * 128 + cw; *(f32x4*)o = a; *(f32x4*)(o + 4) = b;
                            bf16_t* v = vt + (size_t)8 * 128 * SEQ + (((size_t)(b_ * 8 + head)) * 128 + cw) * 16 + t_;
#pragma unroll
                            for (int j = 0; j < 4; ++j) { v[j * 16] = to_bf16(a[j]); v[(4 + j) * 16] = to_bf16(b[j]); }
                        }
                    }
                } else if (seg == 3 || seg == 4) {
                    const int head = sub, pos = samp ? PAST + t_ : row;
                    const float* cs = rope + (size_t)pos * 128 + cw; const float* sn = cs + (size_t)SEQ * 128;
                    const f32x4 c0 = *(const f32x4*)cs, c1 = *(const f32x4*)(cs + 4), s0 = *(const f32x4*)sn, s1 = *(const f32x4*)(sn + 4);
                    const float sc = seg == 3 ? r : r * 0.0625f;
                    const f32x4 xa0 = acc[ai][0][m][0] * sc, xa1 = acc[ai][0][m][1] * sc, xb0 = acc[ai][1][m][0] * sc, xb1 = acc[ai][1][m][1] * sc;
                    const f32x4 lo0 = xa0 * c0 - xb0 * s0, lo1 = xa1 * c1 - xb1 * s1, hi0 = xa0 * s0 + xb0 * c0, hi1 = xa1 * s1 + xb1 * c1;
                    bf16_t* d = (bf16_t*)(ws + (seg == 3 ? WS_RQ : WS_RK));
                    const size_t idx = !samp ? ((size_t)head * SEQ + row) * 256 + cw : (size_t)4 * SEQ * 256 + (((size_t)(b_ * 4 + head)) * 16 + t_) * 256 + cw;
                    u32x4 w; w.x = pk_bf16(lo0[0], lo0[1]); w.y = pk_bf16(lo0[2], lo0[3]); w.z = pk_bf16(lo1[0], lo1[1]); w.w = pk_bf16(lo1[2], lo1[3]);
                    *(u32x4*)(d + idx) = w;
                    w.x = pk_bf16(hi0[0], hi0[1]); w.y = pk_bf16(hi0[2], hi0[3]); w.z = pk_bf16(hi1[0], hi1[1]); w.w = pk_bf16(hi1[2], hi1[3]);
                    *(u32x4*)(d + idx + 128) = w;
                    if (seg == 4) {
                        const float kd = exp2f(log2_gamma(head) * (float)(samp ? 15 - t_ : 63 - (row & 63)));
                        bf16_t* kt = (bf16_t*)(ws + WS_RKDT);
                        if (!samp) { bf16_t* v = kt + ((size_t)head * 256 + cw) * SEQ + row;
#pragma unroll
                            for (int j = 0; j < 4; ++j) { v[(size_t)j * SEQ] = to_bf16(lo0[j] * kd); v[(size_t)(4 + j) * SEQ] = to_bf16(lo1[j] * kd);
                                v[(size_t)(128 + j) * SEQ] = to_bf16(hi0[j] * kd); v[(size_t)(132 + j) * SEQ] = to_bf16(hi1[j] * kd); }
                        } else { bf16_t* v = kt + (size_t)4 * 256 * SEQ + (((size_t)(b_ * 4 + head)) * 256 + cw) * 16 + t_;
#pragma unroll
                            for (int j = 0; j < 4; ++j) { v[j * 16] = to_bf16(lo0[j] * kd); v[(4 + j) * 16] = to_bf16(lo1[j] * kd);
                                v[(128 + j) * 16] = to_bf16(hi0[j] * kd); v[(132 + j) * 16] = to_bf16(hi1[j] * kd); }
                        }
                    }
                } else if (seg == 5) {
                    const int head = sub; bf16_t* vt = (bf16_t*)(ws + WS_RVT);
#pragma unroll
                    for (int bj = 0; bj < 2; ++bj) {
                        const f32x4 a = acc[ai][bj][m][0] * r, b = acc[ai][bj][m][1] * r;
                        if (!samp) { bf16_t* v = vt + ((size_t)head * 256 + bj * 128 + cw) * SEQ + row;
#pragma unroll
                            for (int j = 0; j < 4; ++j) { v[(size_t)j * SEQ] = to_bf16(a[j]); v[(size_t)(4 + j) * SEQ] = to_bf16(b[j]); }
                        } else { bf16_t* v = vt + (size_t)4 * 256 * SEQ + (((size_t)(b_ * 4 + head)) * 256 + bj * 128 + cw) * 16 + t_;
#pragma unroll
                            for (int j = 0; j < 4; ++j) { v[j * 16] = to_bf16(a[j]); v[(4 + j) * 16] = to_bf16(b[j]); }
                        }
                    }
                } else {
                    bf16_t* g = (bf16_t*)(ws + WS_G);
#pragma unroll
                    for (int bj = 0; bj < 2; ++bj) {
                        const f32x4 a = acc[ai][bj][m][0] * r, b = acc[ai][bj][m][1] * r;
                        u32x4 w; w.x = pk_bf16(silu_f(a[0]), silu_f(a[1])); w.y = pk_bf16(silu_f(a[2]), silu_f(a[3])); w.z = pk_bf16(silu_f(b[0]), silu_f(b[1])); w.w = pk_bf16(silu_f(b[2]), silu_f(b[3]));
                        *(u32x4*)(g + (size_t)row * 1024 + sub * 256 + bj * 128 + cw) = w;
                    }
                }
                asm volatile("" ::: "memory");
            }
        }
    }
};

#define MFMA32(a, b, c) __builtin_amdgcn_mfma_f32_32x32x16_bf16((a), (b), (c), 0, 0, 0)

struct TJob { const float* src; const float* gain; bf16_t* dst; int ld, lddst, k0, n0, mode; };
struct KP { const float* in[20]; float* out; unsigned char* ws; };
DI void tconv_load(const TJob& j, int tid, f32x4 (&v)[8]) {
    const int c4 = tid & 63, r = tid >> 6;
#pragma unroll
    for (int p = 0; p < 8; ++p) v[p] = *(const f32x4*)(j.src + (size_t)(j.k0 + r + 8 * p) * j.ld + j.n0 + c4 * 4);
}
DI void tconv_put(const TJob& j, int tid, const f32x4 (&v)[8], float* tile) {
    const int c4 = tid & 63, r = tid >> 6;
#pragma unroll
    for (int p = 0; p < 8; ++p) { f32x4 x = v[p]; if (j.gain) x *= j.gain[j.k0 + r + 8 * p]; *(f32x4*)(tile + (r + 8 * p) * 256 + ((c4 ^ p) << 2)) = x; }
}
DI void tconv_store(const TJob& j, int tid, const float* tile) {
#pragma unroll
    for (int q = 0; q < 4; ++q) {
        const int idx = tid + 512 * q, n = idx >> 3, kg = idx & 7;
        const float* t = tile + kg * 8 * 256 + (((n >> 2) ^ kg) << 2) + (n & 3);
        u32x4 w; w.x = pk_bf16(t[0], t[256]); w.y = pk_bf16(t[512], t[768]); w.z = pk_bf16(t[1024], t[1280]); w.w = pk_bf16(t[1536], t[1792]);
        const int nn = j.n0 + n, R = j.mode == 0 ? nn : 256 * (nn >> 7) + 128 * (j.mode - 1) + (nn & 127);
        *(u32x4*)(j.dst + (size_t)R * j.lddst + j.k0 + kg * 8) = w;
    }
}
constexpr int TC_GU = 32 * 22, TC_DN = 88 * 8, TC_IN = 32 * 28, TC_O = 32 * 8;
constexpr int TN1 = 2 * TC_GU, TN2 = TN1 + TC_DN, TN3 = TN2 + TC_IN, TN4 = TN3 + TC_O, TN5 = TN4 + TC_DN, TN6 = TN5 + 2 * TC_GU;
DI TJob tconv_job(const KP& p, int t) {
    TJob j; unsigned char* ws = p.ws;
    if (t < TN1 || t >= TN5) {
        const bool second = t >= TN5; int tt = second ? t - TN5 : t; const int up = tt >= TC_GU; if (up) tt -= TC_GU;
        j.src = p.in[second ? (up ? 17 : 16) : (up ? 7 : 6)]; j.gain = p.in[second ? 15 : 5]; j.dst = (bf16_t*)(ws + (second ? WS_W2T : WS_W1T));
        j.ld = DFF; j.lddst = DM; j.k0 = (tt / 22) * 64; j.n0 = (tt % 22) * 256; j.mode = 1 + up;
    } else if (t < TN2 || t >= TN4) {
        const bool second = t >= TN4; const int tt = second ? t - TN4 : t - TN1;
        j.src = p.in[second ? 18 : 8]; j.gain = nullptr; j.dst = (bf16_t*)(ws + (second ? WS_WD2T : WS_WD1T)); j.ld = DM; j.lddst = DFF; j.k0 = (tt >> 3) * 64; j.n0 = (tt & 7) * 256; j.mode = 0;
    } else if (t < TN3) { const int tt = t - TN2;
        j.src = p.in[10]; j.gain = p.in[9]; j.dst = (bf16_t*)(ws + WS_WINT); j.ld = DIN; j.lddst = DM; j.k0 = (tt / 28) * 64; j.n0 = (tt % 28) * 256; j.mode = 0;
    } else { const int tt = t - TN3;
        j.src = p.in[14]; j.gain = nullptr; j.dst = (bf16_t*)(ws + WS_WOT); j.ld = DM; j.lddst = DM; j.k0 = (tt >> 3) * 64; j.n0 = (tt & 7) * 256; j.mode = 0;
    }
    return j;
}
DI void tconv_run(const KP& p, float* tile, int tid, int lo, int hi, int worker, int nworkers) {
    const int t0 = lo + worker;
    if (t0 >= hi) return;
    f32x4 v[8]; TJob cur = tconv_job(p, t0);
    tconv_load(cur, tid, v);
    for (int t = t0; t < hi; t += nworkers) {
        tconv_put(cur, tid, v, tile);
        TJob nxt = cur;
        if (t + nworkers < hi) { nxt = tconv_job(p, t + nworkers); tconv_load(nxt, tid, v); }
        __syncthreads();
        tconv_store(cur, tid, tile);
        __syncthreads();
        cur = nxt;
    }
}

DI void phase0(const KP& p, float* tile, int tid) {
    const int G = gridDim.x, bid = blockIdx.x;
    unsigned char* ws = p.ws;
    tconv_run(p, tile, tid, 0, TN2, bid, G);
    const int lane = tid & 63, wave = tid >> 6, gw = bid * 8 + wave, nw = G * 8;
    float* ssq = (float*)(ws + WS_SSQ); bf16_t* xn = (bf16_t*)(ws + WS_XN);
    for (int row = gw; row < MTOK; row += nw) {
        const float* x = row < SEQ ? p.in[0] + (size_t)row * DM : p.in[1] + (size_t)(row - SEQ) * DM;
        float sq = 0.f;
#pragma unroll
        for (int i = 0; i < 4; ++i) {
            const f32x4 a = *(const f32x4*)(x + i * 512 + lane * 8), b = *(const f32x4*)(x + i * 512 + lane * 8 + 4);
            sq += (a[0] * a[0] + a[1] * a[1]) + (a[2] * a[2] + a[3] * a[3]) + (b[0] * b[0] + b[1] * b[1]) + (b[2] * b[2] + b[3] * b[3]);
            u32x4 w; w.x = pk_bf16(a[0], a[1]); w.y = pk_bf16(a[2], a[3]); w.z = pk_bf16(b[0], b[1]); w.w = pk_bf16(b[2], b[3]);
            *(u32x4*)(xn + (size_t)row * DM + i * 512 + lane * 8) = w;
        }
#pragma unroll
        for (int o = 32; o >= 1; o >>= 1) sq += __shfl_xor(sq, o);
        if (lane == 0) { ssq[row] = sq; ssq[MTOK + row] = 0.f; ssq[2 * MTOK + row] = 0.f; ssq[3 * MTOK + row] = 0.f; }
    }
    float* rope = (float*)(ws + WS_ROPE);
    for (int e = bid * 512 + tid; e < SEQ * 128; e += G * 512) {
        const int pos = e >> 7, i = e & 127;
        const float inv = exp2f(-(float)i * (13.287712379549449f / 128.0f));
        const float ang = (float)pos * inv;
        const double rev = (double)ang * 0.15915494309189535; const float fr = (float)(rev - floor(rev));
        rope[e] = __builtin_amdgcn_cosf(fr); rope[(size_t)SEQ * 128 + e] = __builtin_amdgcn_sinf(fr);
    }
}

DI float sb_weights(f32x16& st, float R, int p0, int qpos, int kend, int hl) {
    float lk[16], gs[4], og[4], aft[4];
#pragma unroll
    for (int g = 0; g < 4; ++g) {
        gs[g] = 0.f;
#pragma unroll
        for (int e = 0; e < 4; ++e) {
            const int kpos = p0 + 8 * g + 4 * hl + e; const bool valid = kpos < qpos && kpos < kend;
            const float l = valid ? -softplus_f(st[4 * g + e]) : 0.f; lk[4 * g + e] = l; gs[g] += l;
        }
        og[g] = __shfl_xor(gs[g], 32);
    }
    float tot = 0.f;
#pragma unroll
    for (int g = 3; g >= 0; --g) { aft[g] = tot; tot += gs[g] + og[g]; }
#pragma unroll
    for (int g = 0; g < 4; ++g) {
        float run = R + aft[g] + (hl == 0 ? og[g] : 0.f);
#pragma unroll
        for (int e = 3; e >= 0; --e) {
            const int kpos = p0 + 8 * g + 4 * hl + e; const bool valid = kpos < qpos && kpos < kend;
            run += lk[4 * g + e];
            st[4 * g + e] = valid ? __expf(st[4 * g + e] + run) : 0.f;
        }
    }
    return tot;
}
DI bf16x8 pack_half(const f32x16& st, int s2) {
    u32x4 w;
    if (s2 == 0) { w.x = pk_bf16(st[0], st[1]); w.y = pk_bf16(st[2], st[3]); w.z = pk_bf16(st[4], st[5]); w.w = pk_bf16(st[6], st[7]); }
    else { w.x = pk_bf16(st[8], st[9]); w.y = pk_bf16(st[10], st[11]); w.z = pk_bf16(st[12], st[13]); w.w = pk_bf16(st[14], st[15]); }
    return __builtin_bit_cast(bf16x8, w);
}
DI void sb_store(const f32x16 (&o)[4], bf16_t* out, int r, int hl) {
#pragma unroll
    for (int dt = 0; dt < 4; ++dt)
#pragma unroll
        for (int g = 0; g < 4; ++g) {
            u32x2 w; w.x = pk_bf16(o[dt][4 * g], o[dt][4 * g + 1]); w.y = pk_bf16(o[dt][4 * g + 2], o[dt][4 * g + 3]);
            *(u32x2*)(out + (size_t)r * DM + dt * 32 + 8 * g + 4 * hl) = w;
        }
}
DI void sb_unit_prompt(const bf16_t* q, const bf16_t* kb, const bf16_t* vt, bf16_t* out, int t0, int lane_) {
    int lane = lane_; asm volatile("" : "+v"(lane));
    const int r = lane & 31, hl = lane >> 5, qpos = t0 + r;
    bf16x8 qf[8], kf[8];
#pragma unroll
    for (int ks = 0; ks < 8; ++ks) qf[ks] = *(const bf16x8*)(q + (size_t)r * 128 + ks * 16 + hl * 8);
#pragma unroll
    for (int ks = 0; ks < 8; ++ks) kf[ks] = *(const bf16x8*)(kb + (size_t)(t0 + r) * 128 + ks * 16 + hl * 8);
    f32x16 o[4];
#pragma unroll
    for (int d = 0; d < 4; ++d)
#pragma unroll
        for (int i = 0; i < 16; ++i) o[d][i] = 0.f;
    float R = 0.f;
    for (int p0 = t0; p0 >= 0; p0 -= 32) {
        s16x4 vlo[2][4], vhi[2][4];
#pragma unroll
        for (int s2 = 0; s2 < 2; ++s2)
#pragma unroll
            for (int dt = 0; dt < 4; ++dt) { const bf16_t* vp = vt + (size_t)(dt * 32 + r) * SEQ + p0 + 16 * s2 + 4 * hl; vlo[s2][dt] = *(const s16x4*)vp; vhi[s2][dt] = *(const s16x4*)(vp + 8); }
        f32x16 st;
#pragma unroll
        for (int i = 0; i < 16; ++i) st[i] = 0.f;
#pragma unroll
        for (int ks = 0; ks < 8; ++ks) st = MFMA32(kf[ks], qf[ks], st);
        if (p0 >= 32) {
#pragma unroll
            for (int ks = 0; ks < 8; ++ks) kf[ks] = *(const bf16x8*)(kb + (size_t)(p0 - 32 + r) * 128 + ks * 16 + hl * 8);
        }
        R += sb_weights(st, R, p0, qpos, SEQ, hl);
#pragma unroll
        for (int s2 = 0; s2 < 2; ++s2) {
            const bf16x8 pf = pack_half(st, s2);
#pragma unroll
            for (int dt = 0; dt < 4; ++dt) o[dt] = MFMA32(__builtin_shufflevector(vlo[s2][dt], vhi[s2][dt], 0, 1, 2, 3, 4, 5, 6, 7), pf, o[dt]);
        }
        if (__ballot(R > -110.f) == 0ull) break;
    }
    sb_store(o, out, r, hl);
}
DI void sb_unit_sample(const bf16_t* q, const bf16_t* kn, const bf16_t* vtn, const float* kc, const float* vc, bf16_t* out, int lane_) {
    int lane = lane_; asm volatile("" : "+v"(lane));
    const int r = lane & 31, hl = lane >> 5, qr = r & 15, qpos = PAST + qr;
    bf16x8 qf[8];
#pragma unroll
    for (int ks = 0; ks < 8; ++ks) qf[ks] = *(const bf16x8*)(q + (size_t)qr * 128 + ks * 16 + hl * 8);
    f32x16 o[4];
#pragma unroll
    for (int d = 0; d < 4; ++d)
#pragma unroll
        for (int i = 0; i < 16; ++i) o[d][i] = 0.f;
    float R = 0.f;
    {
        f32x16 st;
#pragma unroll
        for (int i = 0; i < 16; ++i) st[i] = 0.f;
#pragma unroll
        for (int ks = 0; ks < 8; ++ks) st = MFMA32(*(const bf16x8*)(kn + (size_t)qr * 128 + ks * 16 + hl * 8), qf[ks], st);
        R += sb_weights(st, R, PAST, qpos, PAST + DECS, hl);
        const bf16x8 pf = pack_half(st, 0);
#pragma unroll
        for (int dt = 0; dt < 4; ++dt) { const bf16_t* vp = vtn + (size_t)(dt * 32 + r) * 16 + 4 * hl; o[dt] = MFMA32(__builtin_shufflevector(*(const s16x4*)vp, *(const s16x4*)(vp + 8), 0, 1, 2, 3, 4, 5, 6, 7), pf, o[dt]); }
    }
    for (int p0 = PAST - 32; p0 >= 0; p0 -= 32) {
        f32x16 st;
#pragma unroll
        for (int i = 0; i < 16; ++i) st[i] = 0.f;
        const float* kp = kc + (size_t)(p0 + r) * 128 + hl * 8;
        f32x4 kx[16];
#pragma unroll
        for (int i = 0; i < 16; ++i) kx[i] = *(const f32x4*)(kp + (i >> 1) * 16 + (i & 1) * 4);
        bf16x8 qg[8];
#pragma unroll
        for (int ks = 0; ks < 8; ++ks) qg[ks] = *(const bf16x8*)(q + (size_t)qr * 128 + ks * 16 + hl * 8);
        asm volatile("" ::: "memory");
        float vv[2][4][8];
#pragma unroll
        for (int dt = 0; dt < 4; ++dt) { const float* vp = vc + (size_t)(p0 + 4 * hl) * 128 + dt * 32 + r;
#pragma unroll
            for (int j = 0; j < 8; ++j) vv[0][dt][j] = vp[(size_t)(8 * (j >> 2) + (j & 3)) * 128]; }
#pragma unroll
        for (int ks = 0; ks < 8; ++ks) {
            u32x4 w; w.x = pk_bf16(kx[2 * ks][0], kx[2 * ks][1]); w.y = pk_bf16(kx[2 * ks][2], kx[2 * ks][3]); w.z = pk_bf16(kx[2 * ks + 1][0], kx[2 * ks + 1][1]); w.w = pk_bf16(kx[2 * ks + 1][2], kx[2 * ks + 1][3]);
            st = MFMA32(__builtin_bit_cast(bf16x8, w), qg[ks], st);
        }
        asm volatile("" ::: "memory");
#pragma unroll
        for (int dt = 0; dt < 4; ++dt) { const float* vp = vc + (size_t)(p0 + 16 + 4 * hl) * 128 + dt * 32 + r;
#pragma unroll
            for (int j = 0; j < 8; ++j) vv[1][dt][j] = vp[(size_t)(8 * (j >> 2) + (j & 3)) * 128]; }
        R += sb_weights(st, R, p0, qpos, PAST + DECS, hl);
#pragma unroll
        for (int s2 = 0; s2 < 2; ++s2) {
            const bf16x8 pf = pack_half(st, s2);
#pragma unroll
            for (int dt = 0; dt < 4; ++dt) {
                u32x4 v; v.x = pk_bf16(vv[s2][dt][0], vv[s2][dt][1]); v.y = pk_bf16(vv[s2][dt][2], vv[s2][dt][3]); v.z = pk_bf16(vv[s2][dt][4], vv[s2][dt][5]); v.w = pk_bf16(vv[s2][dt][6], vv[s2][dt][7]);
                o[dt] = MFMA32(__builtin_bit_cast(bf16x8, v), pf, o[dt]);
            }
        }
        if (__ballot(R > -110.f) == 0ull) break;
    }
    if (r < 16) sb_store(o, out, r, hl);
}

DI void reta_unit(const KP& p, int item, int w, int lane_) {
    int lane = lane_; asm volatile("" : "+v"(lane));
    const int r = lane & 31, hl = lane >> 5;
    const bool samp = item >= 512;
    const bf16_t* kt = (const bf16_t*)(p.ws + WS_RKDT); const bf16_t* vt = (const bf16_t*)(p.ws + WS_RVT);
    if (!samp) {
        const int h = item >> 7, c = item & 127;
        const bf16_t* ka = kt + ((size_t)h * 256 + w * 32 + r) * SEQ + c * 64 + hl * 8;
        const bf16_t* vb = vt + ((size_t)h * 256 + r) * SEQ + c * 64 + hl * 8;
        bf16x8 A[4];
#pragma unroll
        for (int ks = 0; ks < 4; ++ks) A[ks] = *(const bf16x8*)(ka + ks * 16);
        bf16_t* o = (bf16_t*)(p.ws + WS_KVT) + (size_t)item * 65536;
#pragma unroll 4
        for (int d = 0; d < 8; ++d) {
            f32x16 acc;
#pragma unroll
            for (int i = 0; i < 16; ++i) acc[i] = 0.f;
#pragma unroll
            for (int ks = 0; ks < 4; ++ks) acc = MFMA32(A[ks], *(const bf16x8*)(vb + (size_t)d * 32 * SEQ + ks * 16), acc);
#pragma unroll
            for (int g = 0; g < 4; ++g) {
                u32x2 v; v.x = pk_bf16(acc[4 * g], acc[4 * g + 1]); v.y = pk_bf16(acc[4 * g + 2], acc[4 * g + 3]);
                *(u32x2*)(o + (size_t)(d * 32 + r) * 256 + w * 32 + 8 * g + 4 * hl) = v;
            }
        }
    } else {
        const int it = item - 512, h = it & 3;
        const bf16_t* ka = kt + (size_t)4 * 256 * SEQ + ((size_t)it * 256 + w * 32 + r) * 16 + hl * 8;
        const bf16_t* vb = vt + (size_t)4 * 256 * SEQ + ((size_t)it * 256 + r) * 16 + hl * 8;
        const bf16x8 A = *(const bf16x8*)ka;
        const float cdec = exp2f(log2_gamma(h) * 16.0f);
        const float* s0 = p.in[4] + (size_t)it * 65536; float* o = p.out + O_SS + (size_t)it * 65536;
#pragma unroll 1
        for (int d = 0; d < 8; ++d) {
            f32x16 acc;
#pragma unroll
            for (int i = 0; i < 16; ++i) acc[i] = 0.f;
            acc = MFMA32(A, *(const bf16x8*)(vb + (size_t)d * 32 * 16), acc);
#pragma unroll
            for (int i = 0; i < 16; ++i) {
                const size_t idx = (size_t)(w * 32 + (i & 3) + 8 * (i >> 2) + 4 * hl) * 256 + d * 32 + r;
                o[idx] = cdec * s0[idx] + acc[i];
            }
        }
    }
}

DI void scan_phase(const KP& p, int tid) {
    const bf16_t* kv = (const bf16_t*)(p.ws + WS_KVT); bf16_t* st = (bf16_t*)(p.ws + WS_ST);
    for (int e2 = blockIdx.x * 512 + tid; e2 < 4 * 32768; e2 += gridDim.x * 512) {
        const int h = e2 >> 15, e = (e2 & 32767) * 2;
        const float cdec = exp2f(log2_gamma(h) * 64.0f);
        float s0 = 0.f, s1 = 0.f;
        const size_t base = (size_t)h * 128 * 65536 + e;
#pragma unroll 32
        for (int c = 0; c < 128; ++c) {
            const unsigned kvv = *(const unsigned*)(kv + base + (size_t)c * 65536);
            *(unsigned*)(st + base + (size_t)c * 65536) = pk_bf16(s0, s1);
            s0 = cdec * s0 + __uint_as_float(kvv << 16); s1 = cdec * s1 + __uint_as_float(kvv & 0xffff0000u);
        }
        const int dv = e >> 8, dk = e & 255;
        float* o = p.out + O_SP + (size_t)h * 65536;
        o[(size_t)dk * 256 + dv] = s0; o[(size_t)(dk + 1) * 256 + dv] = s1;
    }
}

struct RcArgs {
    const bf16_t* q; int nq; int i0;
    const bf16_t* k; int nk;
    const bf16_t* vt; int ldv;
    const bf16_t* st;
    float l2g;
    const float* gain;
    const bf16_t* gate;
    bf16_t* out;
};
DI void retc_unit(const RcArgs& a, int lane_) {
    int lane = lane_; asm volatile("" : "+v"(lane));
    const int r = lane & 31, hl = lane >> 5;
    const int qr = r < a.nq ? r : a.nq - 1, qi = a.i0 + qr;
    const bf16_t* qp = a.q + (size_t)qr * 256 + hl * 8;
    f32x16 acc[8];
#pragma unroll
    for (int d = 0; d < 8; ++d)
#pragma unroll
        for (int i = 0; i < 16; ++i) acc[d][i] = 0.f;
#pragma unroll 2
    for (int ks = 0; ks < 16; ++ks) {
        const bf16x8 B = *(const bf16x8*)(qp + ks * 16);
#pragma unroll
        for (int d = 0; d < 8; ++d) acc[d] = MFMA32(*(const bf16x8*)(a.st + (size_t)(d * 32 + r) * 256 + ks * 16 + hl * 8), B, acc[d]);
    }
    const float qdec = exp2f(a.l2g * (float)(qi + 1));
#pragma unroll
    for (int d = 0; d < 8; ++d)
#pragma unroll
        for (int i = 0; i < 16; ++i) acc[d][i] *= qdec;
    const int nblk = (a.i0 + a.nq + 31) >> 5;
    for (int jb = 0; jb < nblk; ++jb) {
        f32x16 st;
#pragma unroll
        for (int i = 0; i < 16; ++i) st[i] = 0.f;
        int kr = jb * 32 + r; kr = kr < a.nk ? kr : a.nk - 1;
        const bf16_t* kp = a.k + (size_t)kr * 256 + hl * 8;
#pragma unroll 4
        for (int ks = 0; ks < 16; ++ks) st = MFMA32(*(const bf16x8*)(kp + ks * 16), *(const bf16x8*)(qp + ks * 16), st);
#pragma unroll
        for (int i = 0; i < 16; ++i) {
            const int j = jb * 32 + (i & 3) + 8 * (i >> 2) + 4 * hl;
            st[i] = (j <= qi && j < a.nk) ? st[i] * exp2f(a.l2g * (float)(qi - j)) : 0.f;
        }
#pragma unroll
        for (int s2 = 0; s2 < 2; ++s2) {
            if (jb * 32 + 16 * s2 < a.nk) {
                u32x4 w; w.x = pk_bf16(st[8 * s2 + 0], st[8 * s2 + 1]); w.y = pk_bf16(st[8 * s2 + 2], st[8 * s2 + 3]); w.z = pk_bf16(st[8 * s2 + 4], st[8 * s2 + 5]); w.w = pk_bf16(st[8 * s2 + 6], st[8 * s2 + 7]);
                const bf16x8 pf = __builtin_bit_cast(bf16x8, w);
#pragma unroll
                for (int d = 0; d < 8; ++d) {
                    const bf16_t* vp = a.vt + (size_t)(d * 32 + r) * a.ldv + jb * 32 + 16 * s2 + 4 * hl;
                    const s16x4 lo = *(const s16x4*)vp, hi = *(const s16x4*)(vp + 8);
                    acc[d] = MFMA32(__builtin_shufflevector(lo, hi, 0, 1, 2, 3, 4, 5, 6, 7), pf, acc[d]);
                }
            }
        }
    }
    float ss = 0.f;
#pragma unroll
    for (int d = 0; d < 8; ++d)
#pragma unroll
        for (int i = 0; i < 16; ++i) ss += acc[d][i] * acc[d][i];
    ss += __shfl_xor(ss, 32);
    const float rs = rsqrtf(ss * (1.0f / 256.0f) + EPS);
    if (r < a.nq) {
#pragma unroll
        for (int d = 0; d < 8; ++d)
#pragma unroll
            for (int g = 0; g < 4; ++g) {
                const int dv = d * 32 + 8 * g + 4 * hl;
                const f32x4 gn = *(const f32x4*)(a.gain + dv);
                const u32x2 gt = *(const u32x2*)(a.gate + (size_t)r * 1024 + dv);
                const float g0 = __uint_as_float(gt.x << 16), g1 = __uint_as_float(gt.x & 0xffff0000u), g2 = __uint_as_float(gt.y << 16), g3 = __uint_as_float(gt.y & 0xffff0000u);
                u32x2 w; w.x = pk_bf16(acc[d][4 * g] * rs * gn[0] * g0, acc[d][4 * g + 1] * rs * gn[1] * g1); w.y = pk_bf16(acc[d][4 * g + 2] * rs * gn[2] * g2, acc[d][4 * g + 3] * rs * gn[3] * g3);
                *(u32x2*)(a.out + (size_t)r * DM + dv) = w;
            }
    }
}

#define XB_TMO      128
#define XB_XCNT(j)  (256  + 64 * (j))
#define XB_XSUB(j)  (1280 + 64 * (j))
#define XB_XGEN(j)  (2304 + 64 * (j))
#define XB_TOP      3328
#define XB_TOPGEN   3392
#define XCD_BAR_WORDS 3456
#define XB_SPIN_CAP (1u << 18)
#define XLAS __attribute__((address_space(3)))

__device__ __forceinline__ unsigned xb_ld(unsigned* p)              { return __hip_atomic_load(p, __ATOMIC_RELAXED, __HIP_MEMORY_SCOPE_AGENT); }
__device__ __forceinline__ unsigned xb_add(unsigned* p, unsigned v) { return __hip_atomic_fetch_add(p, v, __ATOMIC_RELAXED, __HIP_MEMORY_SCOPE_AGENT); }
__device__ __forceinline__ unsigned xb_xcc_id() { return (unsigned)__builtin_amdgcn_s_getreg((3 << 11) | 20) & 0xFu; }
#define XB_SPIN(cond, bar) do { unsigned _sp = 0; while (cond) { __builtin_amdgcn_s_sleep(1); \
    if ((++_sp & 255u) == 0u) { if (xb_ld(&(bar)[XB_TMO])) break; if (_sp > XB_SPIN_CAP) { atomicAdd(&(bar)[XB_TMO], 1u); break; } } } } while (0)

struct XcdBarrier {
    unsigned* bar; unsigned x;
    volatile XLAS unsigned* st;
};

__device__ __forceinline__ XcdBarrier xcd_barrier_post(unsigned* bar, volatile XLAS unsigned* st) {
    XcdBarrier b; b.bar = bar; b.x = xb_xcc_id(); b.st = st;
    if (threadIdx.x == 0) (void)xb_add(&bar[XB_XCNT(b.x)], 1u);
    return b;
}
__device__ __forceinline__ void xcd_barrier_complete(unsigned* bar, unsigned x, unsigned& nloc, unsigned& nx) {
    const unsigned G = gridDim.x * gridDim.y * gridDim.z;
    unsigned sum, cnt, mine, sp = 0u;
    for (;;) {
        sum = 0u; cnt = 0u; mine = 0u;
#pragma unroll
        for (unsigned j = 0; j < 16; ++j) { const unsigned c = xb_ld(&bar[XB_XCNT(j)]); sum += c; cnt += (c > 0u) ? 1u : 0u; mine = (j == x) ? c : mine; }
        if (sum == G) break;
        __builtin_amdgcn_s_sleep(1);
        if ((++sp & 255u) == 0u) { if (xb_ld(&bar[XB_TMO])) break; if (sp > XB_SPIN_CAP) { atomicAdd(&bar[XB_TMO], 1u); break; } }
    }
    nloc = mine > 0u ? mine : 1u; nx = cnt > 0u ? cnt : 1u;
}

__device__ __forceinline__ void xcd_barrier(const XcdBarrier& b) {
    asm volatile("s_waitcnt vmcnt(0)" ::: "memory");
    __syncthreads();
    if (threadIdx.x == 0) {
        unsigned* bar = b.bar;
        __builtin_amdgcn_s_waitcnt(0);
        unsigned nloc = b.st[0], nx = b.st[1];
        if (nloc == 0u) { xcd_barrier_complete(bar, b.x, nloc, nx); b.st[0] = nloc; b.st[1] = nx; }
        const unsigned old = xb_add(&bar[XB_XSUB(b.x)], 1u);
        const unsigned gen = old / nloc;
        if (old + 1u == (gen + 1u) * nloc) {
            __builtin_amdgcn_fence(__ATOMIC_RELEASE, "agent");
            asm volatile("s_waitcnt vmcnt(0)" ::: "memory");
            const unsigned og = xb_add(&bar[XB_TOP], 1u);
            const unsigned tg = og / nx;
            if (og + 1u == (tg + 1u) * nx) xb_add(&bar[XB_TOPGEN], 1u);
            else XB_SPIN(xb_ld(&bar[XB_TOPGEN]) == tg, bar);
            __builtin_amdgcn_fence(__ATOMIC_ACQUIRE, "agent");
            xb_add(&bar[XB_XGEN(b.x)], 1u);
            asm volatile("s_waitcnt vmcnt(0)" ::: "memory");
        } else {
            XB_SPIN(xb_ld(&bar[XB_XGEN(b.x)]) == gen, bar);
            __builtin_amdgcn_fence(__ATOMIC_ACQUIRE, "agent");
            asm volatile("s_waitcnt vmcnt(0)" ::: "memory");
        }
    }
    __syncthreads();
}


template <int K>
DI void skinny_resid(const bf16_t* __restrict__ A, const bf16_t* __restrict__ Bt, const float* xin, float* xo, bf16_t* xb, float* ssq, float scale, float* red, int tid) {
    const int lane = tid & 63, wave = __builtin_amdgcn_readfirstlane(tid >> 6), r = lane & 31, hl = lane >> 5;
    constexpr int Kq = K / 8, UNR = (Kq / 16) % 11 == 0 ? 11 : 8;
    for (int pr = blockIdx.x; pr < 256; pr += gridDim.x) {
        const int rt = pr >> 5, ct0 = (pr & 31) * 2;
        const bf16_t* ap = Bt + (size_t)(ct0 * 32 + r) * K + wave * Kq + hl * 8;
        const bf16_t* bp = A + (size_t)(rt * 32 + r) * K + wave * Kq + hl * 8;
        f32x16 acc0, acc1;
#pragma unroll
        for (int i = 0; i < 16; ++i) { acc0[i] = 0.f; acc1[i] = 0.f; }
#pragma unroll UNR
        for (int k = 0; k < Kq; k += 16) {
            const bf16x8 B = *(const bf16x8*)(bp + k);
            acc0 = MFMA32(*(const bf16x8*)(ap + k), B, acc0);
            acc1 = MFMA32(*(const bf16x8*)(ap + (size_t)32 * K + k), B, acc1);
        }
#pragma unroll
        for (int i = 0; i < 16; ++i) { red[((wave * 2 + 0) * 16 + i) * 64 + lane] = acc0[i]; red[((wave * 2 + 1) * 16 + i) * 64 + lane] = acc1[i]; }
        __syncthreads();
        {
            const int t = wave >> 2, g = wave & 3;
            float v[4];
#pragma unroll
            for (int e = 0; e < 4; ++e) { float sum = 0.f;
#pragma unroll
                for (int w2 = 0; w2 < 8; ++w2) sum += red[((w2 * 2 + t) * 16 + 4 * g + e) * 64 + lane];
                v[e] = sum; }
            const int token = rt * 32 + r;
            const size_t off = (size_t)token * DM + (ct0 + t) * 32 + 8 * g + 4 * hl;
            const f32x4 x = *(const f32x4*)(xin + off);
            f32x4 y; y[0] = x[0] + scale * v[0]; y[1] = x[1] + scale * v[1]; y[2] = x[2] + scale * v[2]; y[3] = x[3] + scale * v[3];
            *(f32x4*)(xo + off) = y;
            u32x2 w; w.x = pk_bf16(y[0], y[1]); w.y = pk_bf16(y[2], y[3]); *(u32x2*)(xb + off) = w;
            float sq = (y[0] * y[0] + y[1] * y[1]) + (y[2] * y[2] + y[3] * y[3]);
            sq += __shfl_xor(sq, 32);
            if (hl == 0) atomicAdd(ssq + token, sq);
        }
        __syncthreads();
    }
}

#define REP_P0 1
#define REP_M1 1
#define REP_SC 1
#define REP_M2 1
#define REP_SK 1
#define REP_FN 1
constexpr int LDS_BYTES = pg8::STAGE_BYTES + 8192 + 16;
__global__ void __launch_bounds__(512, 2) fwd_kernel(KP p) {
    extern __shared__ __attribute__((aligned(16))) unsigned char lds[];
    cg::grid_group grid = cg::this_grid();
    if (p.ws == nullptr) grid.sync();
    if (threadIdx.x < 4) ((volatile XLAS unsigned*)((XLAS unsigned char*)lds + pg8::STAGE_BYTES + 8192))[threadIdx.x] = 0u;
    __syncthreads();
    const XcdBarrier xbar = xcd_barrier_post((unsigned*)(p.ws + WS_BAR), (volatile XLAS unsigned*)((XLAS unsigned char*)lds + pg8::STAGE_BYTES + 8192));
#define GRID_SYNC() xcd_barrier(xbar)
#define FRESH_IDS() int tid = threadIdx.x; asm volatile("" : "+v"(tid)); const int lane = tid & 63, wave = __builtin_amdgcn_readfirstlane(tid >> 6); (void)lane; (void)wave
    const int G = gridDim.x, bid = blockIdx.x;
    PG8_LAS unsigned char* l3 = (PG8_LAS unsigned char*)lds;
#define PHASE_PTRS() unsigned char* ws = p.ws; asm volatile("" : "+s"(ws)); float* ssq = (float*)(ws + WS_SSQ); bf16_t* XN = (bf16_t*)(ws + WS_XN); bf16_t* H = (bf16_t*)(ws + WS_H); \
    float* X1 = (float*)(ws + WS_X1); bf16_t* MIX = (bf16_t*)(ws + WS_MIX); (void)ssq; (void)XN; (void)H; (void)X1; (void)MIX

    for (int rep = 0; rep < REP_P0; ++rep) { FRESH_IDS(); phase0(p, (float*)lds, tid); GRID_SYNC(); }
    {
        PHASE_PTRS();
        pg8::Gemm g{XN, (const bf16_t*)(ws + WS_W1T), MTOK, 2 * DFF, DM}; pg8::StaticOrder S; S.init(MTOK, 2 * DFF, G, bid);
        EpiSwiglu E{H, ssq};
        pg8::gemm_phase<EpiSwiglu, pg8::StaticOrder>(l3, g, S, E, nullptr);
        {
            const int rem = ((MTOK / 256) * (2 * DFF / 256)) % G;
            if (rem && bid >= rem) { FRESH_IDS(); tconv_run(p, (float*)lds, tid, TN2, TN5, bid - rem, G - rem); }
        }
    }
    GRID_SYNC();
    {
        PHASE_PTRS();
        pg8::Gemm g{H, (const bf16_t*)(ws + WS_WD1T), SEQ, DM, DFF}; pg8::StaticOrder S; S.init(SEQ, DM, G, bid);
        EpiResid E{p.in[0], p.in[1], X1, XN, ssq + MTOK, 0.5f};
        pg8::gemm_phase<EpiResid, pg8::StaticOrder>(l3, g, S, E, nullptr);
        { FRESH_IDS(); skinny_resid<DFF>(H + (size_t)SEQ * DFF, (const bf16_t*)(ws + WS_WD1T), p.in[1], X1 + (size_t)SEQ * DM, XN + (size_t)SEQ * DM, ssq + MTOK + SEQ, 0.5f, (float*)lds, tid); }
        for (int rep = 1; rep < REP_SK; ++rep) { FRESH_IDS(); skinny_resid<DFF>(H + (size_t)SEQ * DFF, (const bf16_t*)(ws + WS_WD1T), p.in[1], (float*)(ws + WS_KVT), (bf16_t*)(ws + WS_KVT + (size_t)8 * 1024 * 1024), (float*)(ws + WS_KVT + (size_t)16 * 1024 * 1024), 0.5f, (float*)lds, tid); }
    }
    GRID_SYNC();
    {
        PHASE_PTRS();
        pg8::Gemm g{XN, (const bf16_t*)(ws + WS_WINT), MTOK, DIN, DM}; pg8::StaticOrder S; S.init(MTOK, DIN, G, bid);
        EpiIn E{ssq + MTOK, p.in[11], p.in[12], (const float*)(ws + WS_ROPE), p.out, ws, (float*)(lds + pg8::STAGE_BYTES)};
        pg8::gemm_phase<EpiIn, pg8::StaticOrder>(l3, g, S, E, nullptr);
        {
            const int rem = ((MTOK / 256) * (DIN / 256)) % G;
            if (rem && bid >= rem) { FRESH_IDS(); tconv_run(p, (float*)lds, tid, TN5, TN6, bid - rem, G - rem); }
        }
    }
    GRID_SYNC();
    for (int rep = 0; rep < REP_M1; ++rep) {
        PHASE_PTRS();
        FRESH_IDS();
        for (int tt = bid; tt < 256; tt += G) {
            TJob j; j.src = p.in[4] + (size_t)(tt >> 2) * 65536; j.gain = nullptr; j.dst = (bf16_t*)(ws + WS_ST) + (size_t)(512 + (tt >> 2)) * 65536; j.ld = 256; j.lddst = 256; j.k0 = (tt & 3) * 64; j.n0 = 0; j.mode = 0;
            f32x4 v[8]; tconv_load(j, tid, v); tconv_put(j, tid, v, (float*)lds); __syncthreads(); tconv_store(j, tid, (float*)lds); __syncthreads();
        }
        const int gw = bid * 8 + wave, nw = G * 8;
        constexpr int U_SBS = 128, U_SBP = 8 * 256, U_RA = 576 * 8;
        for (int u = gw; u < U_SBS + U_SBP + U_RA; u += nw) {
            if (u < U_SBS) {
                const int bh = u, b = bh >> 3, h = bh & 7;
                sb_unit_sample((const bf16_t*)(ws + WS_QB) + (size_t)8 * SEQ * 128 + (size_t)bh * 16 * 128, (const bf16_t*)(ws + WS_KB) + (size_t)8 * SEQ * 128 + (size_t)bh * 16 * 128,
                               (const bf16_t*)(ws + WS_VT) + (size_t)8 * 128 * SEQ + (size_t)bh * 128 * 16, p.in[2] + (size_t)bh * PAST * 128, p.in[3] + (size_t)bh * PAST * 128,
                               MIX + (size_t)(SEQ + b * 16) * DM + h * 128, lane);
            } else if (u < U_SBS + U_SBP) {
                const int v = u - U_SBS, h = v & 7, qb = 255 - (v >> 3);
                sb_unit_prompt((const bf16_t*)(ws + WS_QB) + ((size_t)h * SEQ + qb * 32) * 128, (const bf16_t*)(ws + WS_KB) + (size_t)h * SEQ * 128, (const bf16_t*)(ws + WS_VT) + (size_t)h * 128 * SEQ,
                               MIX + (size_t)(qb * 32) * DM + h * 128, qb * 32, lane);
            } else { const int v = u - U_SBS - U_SBP; reta_unit(p, v >> 3, v & 7, lane); }
        }
    }
    GRID_SYNC();
    for (int rep = 0; rep < REP_SC; ++rep) { FRESH_IDS(); scan_phase(p, tid); GRID_SYNC(); }
    for (int rep = 0; rep < REP_M2; ++rep) {
        PHASE_PTRS();
        FRESH_IDS();
        const int gw = bid * 8 + wave, nw = G * 8;
        for (int u = gw; u < 1024 + 64; u += nw) {
            RcArgs a;
            if (u < 1024) {
                const int item = u >> 1, half = u & 1, h = item >> 7, c = item & 127, tok = c * 64 + half * 32;
                a.q = (const bf16_t*)(ws + WS_RQ) + ((size_t)h * SEQ + tok) * 256; a.nq = 32; a.i0 = half * 32;
                a.k = (const bf16_t*)(ws + WS_RK) + ((size_t)h * SEQ + c * 64) * 256; a.nk = 64;
                a.vt = (const bf16_t*)(ws + WS_RVT) + (size_t)h * 256 * SEQ + c * 64; a.ldv = SEQ;
                a.st = (const bf16_t*)(ws + WS_ST) + (size_t)item * 65536; a.l2g = log2_gamma(h); a.gain = p.in[13] + h * 256;
                a.gate = (const bf16_t*)(ws + WS_G) + (size_t)tok * 1024 + h * 256; a.out = MIX + (size_t)tok * DM + 1024 + h * 256;
            } else {
                const int it = u - 1024, b = it >> 2, h = it & 3, row = SEQ + b * 16;
                a.q = (const bf16_t*)(ws + WS_RQ) + (size_t)4 * SEQ * 256 + (size_t)it * 16 * 256; a.nq = 16; a.i0 = 0;
                a.k = (const bf16_t*)(ws + WS_RK) + (size_t)4 * SEQ * 256 + (size_t)it * 16 * 256; a.nk = 16;
                a.vt = (const bf16_t*)(ws + WS_RVT) + (size_t)4 * 256 * SEQ + (size_t)it * 256 * 16; a.ldv = 16;
                a.st = (const bf16_t*)(ws + WS_ST) + (size_t)(512 + it) * 65536; a.l2g = log2_gamma(h); a.gain = p.in[13] + h * 256;
                a.gate = (const bf16_t*)(ws + WS_G) + (size_t)row * 1024 + h * 256; a.out = MIX + (size_t)row * DM + 1024 + h * 256;
            }
            retc_unit(a, lane);
        }
    }
    GRID_SYNC();
    {
        PHASE_PTRS();
        pg8::Gemm g{MIX, (const bf16_t*)(ws + WS_WOT), SEQ, DM, DM}; pg8::StaticOrder S; S.init(SEQ, DM, G, bid);
        EpiResid E{X1, X1 + (size_t)SEQ * DM, X1, XN, ssq + 2 * MTOK, 1.0f};
        pg8::gemm_phase<EpiResid, pg8::StaticOrder>(l3, g, S, E, nullptr);
        { FRESH_IDS(); skinny_resid<DM>(MIX + (size_t)SEQ * DM, (const bf16_t*)(ws + WS_WOT), X1 + (size_t)SEQ * DM, X1 + (size_t)SEQ * DM, XN + (size_t)SEQ * DM, ssq + 2 * MTOK + SEQ, 1.0f, (float*)lds, tid); }
    }
    GRID_SYNC();
    {
        PHASE_PTRS();
        pg8::Gemm g{XN, (const bf16_t*)(ws + WS_W2T), MTOK, 2 * DFF, DM}; pg8::StaticOrder S; S.init(MTOK, 2 * DFF, G, bid);
        EpiSwiglu E{H, ssq + 2 * MTOK};
        pg8::gemm_phase<EpiSwiglu, pg8::StaticOrder>(l3, g, S, E, nullptr);
    }
    GRID_SYNC();
    {
        PHASE_PTRS();
        pg8::Gemm g{H, (const bf16_t*)(ws + WS_WD2T), SEQ, DM, DFF}; pg8::StaticOrder S; S.init(SEQ, DM, G, bid);
        EpiResid E{X1, X1 + (size_t)SEQ * DM, X1, XN, ssq + 3 * MTOK, 0.5f};
        pg8::gemm_phase<EpiResid, pg8::StaticOrder>(l3, g, S, E, nullptr);
        { FRESH_IDS(); skinny_resid<DFF>(H + (size_t)SEQ * DFF, (const bf16_t*)(ws + WS_WD2T), X1 + (size_t)SEQ * DM, X1 + (size_t)SEQ * DM, XN + (size_t)SEQ * DM, ssq + 3 * MTOK + SEQ, 0.5f, (float*)lds, tid); }
    }
    GRID_SYNC();
    for (int rep = 0; rep < REP_FN; ++rep) {
        PHASE_PTRS();
        FRESH_IDS();
        const int gw = bid * 8 + wave, nw = G * 8; const float* fn = p.in[19];
        for (int row = gw; row < MTOK; row += nw) {
            const float rs = rsqrtf(ssq[3 * MTOK + row] * (1.0f / DM) + EPS);
            const float* x = X1 + (size_t)row * DM; float* y = p.out + O_Y + (size_t)row * DM;
#pragma unroll
            for (int i = 0; i < 8; ++i) { const int c = i * 256 + lane * 4; *(f32x4*)(y + c) = *(const f32x4*)(x + c) * rs * *(const f32x4*)(fn + c); }
        }
    }
}

extern "C" void kernel_launch(void* const* d_in, const int* in_sizes, int n_in, void* d_out, int out_size, void* d_ws, size_t ws_size, hipStream_t stream) {
    static int grid_blocks = 0;
    if (!grid_blocks) {
        if (n_in != 20 || ws_size < WS_END) { fprintf(stderr, "kernel_launch: need 20 inputs and %zu bytes of workspace (got %d, %zu)\n", (size_t)WS_END, n_in, ws_size); grid_blocks = -1; return; }
        int dev = 0, cus = 0, per_cu = 0;
        hipGetDevice(&dev);
        hipDeviceGetAttribute(&cus, hipDeviceAttributeMultiprocessorCount, dev);
        hipFuncSetAttribute((const void*)fwd_kernel, hipFuncAttributeMaxDynamicSharedMemorySize, LDS_BYTES);
        hipOccupancyMaxActiveBlocksPerMultiprocessor(&per_cu, (const void*)fwd_kernel, 512, LDS_BYTES);
        if (per_cu < 1) { fprintf(stderr, "kernel_launch: occupancy query says %d blocks per CU\n", per_cu); per_cu = 1; }
        grid_blocks = cus;
    }
    if (grid_blocks < 0) return;
    KP p{};
    for (int i = 0; i < 20; ++i) p.in[i] = (const float*)d_in[i];
    p.out = (float*)d_out; p.ws = (unsigned char*)d_ws;
    if (hipMemsetAsync((char*)d_ws + WS_BAR, 0, 16384, stream) != hipSuccess) { fprintf(stderr, "kernel_launch: memset of the barrier words failed\n"); return; }
    void* args[] = {&p};
    hipError_t e = hipLaunchCooperativeKernel((const void*)fwd_kernel, dim3(grid_blocks), dim3(512), args, LDS_BYTES, stream);
    if (e != hipSuccess) fprintf(stderr, "cooperative launch failed: %s (grid %d)\n", hipGetErrorString(e), grid_blocks);
}
```
